# Optimizing an MI355X kernel written in HIP

```python
import math
import jax, jax.numpy as jnp
from jax import lax
import numpy as np

D_MODEL = 2048
BATCH = 4
SEQ = 4096
DEPTH = 4

HEAD_DIM = 128
MIX_WIDTH = D_MODEL
A_HEADS = 4
A_NOPE = 128
A_ROPE = 64
A_V = 128
Q_LORA_RANK = 448
KV_LORA_RANK = 512
B_HEADS = 6
B_KV_HEADS = 2
B_GROUP = B_HEADS // B_KV_HEADS
GRID_W = 64
C_HEADS = 6
C_BRANCHES = ((128, 1), (512, 4), (2048, 16))
D_FF = 4 * D_MODEL
ROPE_THETA = 10000.0
Q_BLOCK = 128
EPS = 1e-6
NEG_INF = -1e30
IN_SIZES = (Q_LORA_RANK, KV_LORA_RANK, A_ROPE,
            B_HEADS * HEAD_DIM, B_KV_HEADS * HEAD_DIM, B_KV_HEADS * HEAD_DIM,
            C_HEADS * HEAD_DIM, C_HEADS * HEAD_DIM, C_HEADS * HEAD_DIM)
IN_WIDTH = sum(IN_SIZES)
OUT_SIZES = (A_HEADS * A_V, B_HEADS * HEAD_DIM, C_HEADS * HEAD_DIM)

kernel_name = "hymba_style_mla_gqa2d_dilated_encoder"


def _rms(x, g=None):
    xf = x.astype(jnp.float32)
    y = xf * lax.rsqrt(jnp.mean(xf * xf, axis=-1, keepdims=True) + EPS)
    if g is not None:
        y = y * g.astype(jnp.float32)
    return y.astype(x.dtype)


def _rope_angles(pos, dim):
    inv = jnp.power(ROPE_THETA, -jnp.arange(0, dim, 2, dtype=jnp.float32) / dim)
    ang = pos.astype(jnp.float32)[:, None] * inv[None, :]
    return jnp.cos(ang), jnp.sin(ang)


def _apply_rope(x, cs):
    cos, sin = cs
    cos = cos[:, None, :]
    sin = sin[:, None, :]
    xf = x.astype(jnp.float32)
    half = x.shape[-1] // 2
    x1, x2 = xf[..., :half], xf[..., half:]
    return jnp.concatenate([x1 * cos - x2 * sin, x1 * sin + x2 * cos], axis=-1).astype(x.dtype)


def _split_cols(a, sizes):
    out = []
    start = 0
    for s in sizes:
        out.append(a[..., start:start + s])
        start += s
    return out


def _dense_attn_blocked(q, k, v, scale):
    B, S, Hkv, G, Dk = q.shape
    nb = S // Q_BLOCK
    qb = q.reshape(B, nb, Q_BLOCK, Hkv, G, Dk).transpose(1, 0, 2, 3, 4, 5)

    def one_block(qblk):
        s = jnp.einsum('bqhgd,bkhd->bhgqk', qblk, k).astype(jnp.float32) * scale
        p = jax.nn.softmax(s, axis=-1)
        return jnp.einsum('bhgqk,bkhd->bqhgd', p.astype(v.dtype), v)

    ob = lax.map(one_block, qb)
    return ob.transpose(1, 0, 2, 3, 4, 5).reshape(B, S, Hkv, G, v.shape[-1])


def _band_attn(q, k, v, half, scale):
    N, L, H, D = q.shape
    blk = half
    nb = -(-L // blk)
    pad = nb * blk - L
    qp = jnp.pad(q, ((0, 0), (0, pad), (0, 0), (0, 0)))
    kp = jnp.pad(k, ((0, 0), (blk, pad + blk), (0, 0), (0, 0))).reshape(N, nb + 2, blk, H, D)
    vp = jnp.pad(v, ((0, 0), (blk, pad + blk), (0, 0), (0, 0))).reshape(N, nb + 2, blk, H, D)
    kwin = jnp.concatenate([kp[:, :-2], kp[:, 1:-1], kp[:, 2:]], axis=2)
    vwin = jnp.concatenate([vp[:, :-2], vp[:, 1:-1], vp[:, 2:]], axis=2)
    qb = qp.reshape(N, nb, blk, H, D)
    s = jnp.einsum('nbqhd,nbkhd->nbhqk', qb, kwin).astype(jnp.float32) * scale
    qpos = jnp.arange(nb)[:, None] * blk + jnp.arange(blk)[None, :]
    kpos = (jnp.arange(nb)[:, None] - 1) * blk + jnp.arange(3 * blk)[None, :]
    rel = kpos[:, None, :] - qpos[:, :, None]
    mask = (jnp.abs(rel) <= half) & (kpos[:, None, :] >= 0) & (kpos[:, None, :] < L)
    s = jnp.where(mask[None, :, None, :, :], s, NEG_INF)
    m = jnp.max(s, axis=-1, keepdims=True)
    e = jnp.exp(s - m)
    den = jnp.sum(e, axis=-1, keepdims=True)
    o = jnp.einsum('nbhqk,nbkhd->nbqhd', (e / den).astype(v.dtype), vwin)
    lse = (m + jnp.log(den))[..., 0]
    o = o.reshape(N, nb * blk, H, D)[:, :L]
    lse = lse.transpose(0, 1, 3, 2).reshape(N, nb * blk, H)[:, :L]
    return o, lse


def _dilated_mixture(q, k, v, scale):
    B, S, H, D = q.shape
    outs = []
    lses = []
    for window, dil in C_BRANCHES:
        half = window // (2 * dil)
        L = S // dil

        def to_sub(t):
            return t.reshape(B, L, dil, H, D).transpose(0, 2, 1, 3, 4).reshape(B * dil, L, H, D)

        o, lse = _band_attn(to_sub(q), to_sub(k), to_sub(v), half, scale)
        outs.append(o.reshape(B, dil, L, H, D).transpose(0, 2, 1, 3, 4).reshape(B, S, H, D))
        lses.append(lse.reshape(B, dil, L, H).transpose(0, 2, 1, 3).reshape(B, S, H))
    w = jax.nn.softmax(jnp.stack(lses, axis=0), axis=0)
    o = jnp.stack(outs, axis=0).astype(jnp.float32)
    return jnp.sum(w[..., None] * o, axis=0).astype(q.dtype)


def setup_inputs(seed: int = 0) -> dict:
    key = jax.random.key(seed)
    ks = jax.random.split(key, 16)
    f32 = jnp.float32

    def nrm(k, shape, scale):
        return jax.random.normal(k, shape, f32) * scale

    def gain(k, shape):
        return 1.0 + 0.02 * jax.random.normal(k, shape, f32)

    return {
        "x": jax.random.normal(ks[0], (BATCH, SEQ, D_MODEL), f32),
        "ln1_g": gain(ks[1], (DEPTH, D_MODEL)),
        "w_in": nrm(ks[2], (DEPTH, D_MODEL, IN_WIDTH), D_MODEL ** -0.5),
        "g_q_a": gain(ks[3], (DEPTH, Q_LORA_RANK)),
        "w_uq": nrm(ks[4], (DEPTH, Q_LORA_RANK, A_HEADS * (A_NOPE + A_ROPE)), Q_LORA_RANK ** -0.5),
        "g_kv_a": gain(ks[5], (DEPTH, KV_LORA_RANK)),
        "w_ukv": nrm(ks[6], (DEPTH, KV_LORA_RANK, A_HEADS * (A_NOPE + A_V)), KV_LORA_RANK ** -0.5),
        "g_qn_b": gain(ks[7], (DEPTH, HEAD_DIM)),
        "g_kn_b": gain(ks[8], (DEPTH, HEAD_DIM)),
        "g_out": gain(ks[9], (DEPTH, MIX_WIDTH)),
        "w_out": nrm(ks[10], (DEPTH, MIX_WIDTH, D_MODEL), MIX_WIDTH ** -0.5),
        "ln2_g": gain(ks[11], (DEPTH, D_MODEL)),
        "w_ff1": nrm(ks[12], (DEPTH, D_MODEL, D_FF), D_MODEL ** -0.5),
        "w_ff2": nrm(ks[13], (DEPTH, D_FF, D_MODEL), D_FF ** -0.5),
        "ln_f_g": gain(ks[14], (D_MODEL,)),
    }


def reference(x, ln1_g, w_in, g_q_a, w_uq, g_kv_a, w_ukv, g_qn_b, g_kn_b, g_out, w_out,
              ln2_g, w_ff1, w_ff2, ln_f_g):
    B, S, _ = x.shape
    ROWS = S // GRID_W
    pos = jnp.arange(S, dtype=jnp.float32)
    row = jnp.repeat(jnp.arange(ROWS, dtype=jnp.float32), GRID_W)
    col = jnp.tile(jnp.arange(GRID_W, dtype=jnp.float32), ROWS)
    cs_a = _rope_angles(pos, A_ROPE)
    cs_c = _rope_angles(pos, HEAD_DIM)
    cs_row = _rope_angles(row, HEAD_DIM // 2)
    cs_col = _rope_angles(col, HEAD_DIM // 2)
    scale_a = 1.0 / math.sqrt(A_NOPE + A_ROPE)
    scale_h = 1.0 / math.sqrt(HEAD_DIM)

    def axial(t):
        hd = HEAD_DIM // 2
        return jnp.concatenate([_apply_rope(t[..., :hd], cs_row), _apply_rope(t[..., hd:], cs_col)], axis=-1)

    for l in range(DEPTH):
        h = _rms(x, ln1_g[l])
        proj = h @ w_in[l]
        a_cq, a_ckv, a_kr, b_q, b_k, b_v, c_q, c_k, c_v = _split_cols(proj, IN_SIZES)

        qa = (_rms(a_cq, g_q_a[l]) @ w_uq[l]).reshape(B, S, A_HEADS, A_NOPE + A_ROPE)
        qa = jnp.concatenate([qa[..., :A_NOPE], _apply_rope(qa[..., A_NOPE:], cs_a)], axis=-1)
        kva = (_rms(a_ckv, g_kv_a[l]) @ w_ukv[l]).reshape(B, S, A_HEADS, A_NOPE + A_V)
        k_pe = _apply_rope(a_kr[:, :, None, :], cs_a)
        ka = jnp.concatenate([kva[..., :A_NOPE], jnp.broadcast_to(k_pe, (B, S, A_HEADS, A_ROPE))], axis=-1)
        va = kva[..., A_NOPE:]
        o_a = _dense_attn_blocked(qa[:, :, :, None, :], ka, va, scale_a).reshape(B, S, OUT_SIZES[0])

        qb = axial(_rms(b_q.reshape(B, S, B_HEADS, HEAD_DIM), g_qn_b[l]))
        kb = axial(_rms(b_k.reshape(B, S, B_KV_HEADS, HEAD_DIM), g_kn_b[l]))
        vb = b_v.reshape(B, S, B_KV_HEADS, HEAD_DIM)
        qb = qb.reshape(B, S, B_KV_HEADS, B_GROUP, HEAD_DIM)
        o_b = _dense_attn_blocked(qb, kb, vb, scale_h).reshape(B, S, OUT_SIZES[1])

        qc = _apply_rope(c_q.reshape(B, S, C_HEADS, HEAD_DIM), cs_c)
        kc = _apply_rope(c_k.reshape(B, S, C_HEADS, HEAD_DIM), cs_c)
        vc = c_v.reshape(B, S, C_HEADS, HEAD_DIM)
        o_c = _dilated_mixture(qc, kc, vc, scale_h).reshape(B, S, OUT_SIZES[2])

        mixed = jnp.concatenate([_rms(o_a), _rms(o_b), _rms(o_c)], axis=-1) * g_out[l]
        x = x + mixed @ w_out[l]

        u = jnp.square(jax.nn.relu(_rms(x, ln2_g[l]) @ w_ff1[l]))
        x = x + u @ w_ff2[l]

    return _rms(x, ln_f_g)
```

```cpp
#include <hip/hip_runtime.h>
#include <hip/hip_cooperative_groups.h>
#include <cstdio>
#include <cstdint>
namespace cg = cooperative_groups;

typedef unsigned short bf16_t;
typedef short bf16x8 __attribute__((ext_vector_type(8)));
typedef short s16x4 __attribute__((ext_vector_type(4)));
typedef float f32x4 __attribute__((ext_vector_type(4)));
typedef float f32x2 __attribute__((ext_vector_type(2)));
typedef float f32x16 __attribute__((ext_vector_type(16)));
typedef unsigned u32x4 __attribute__((ext_vector_type(4)));
typedef unsigned u32x2 __attribute__((ext_vector_type(2)));
#define LAS __attribute__((address_space(3)))

constexpr int NB = 4, SEQ = 4096, T = NB * SEQ, DM = 2048, INW = 4608, DFF = 8192, DEPTH = 4;
constexpr int C_CQ = 0, C_CKV = 448, C_KR = 960, C_BQ = 1024, C_BK = 1792, C_BV = 2048, C_CQ3 = 2304, C_CK = 3072, C_CV = 3840;
constexpr float EPS = 1e-6f;
constexpr float LOG2E = 1.4426950408889634f;

constexpr size_t al256(size_t x) { return (x + 255) / 256 * 256; }
constexpr size_t WS_CTL = 0;
constexpr size_t WS_TABC = 16384;
constexpr size_t WS_TABA = WS_TABC + (size_t)4096 * 64 * 8;
constexpr size_t WS_WIN = al256(WS_TABA + (size_t)4096 * 32 * 8);
constexpr size_t WS_WUQ = WS_WIN + (size_t)INW * DM * 2;
constexpr size_t WS_WUKV = WS_WUQ + (size_t)768 * 512 * 2;
constexpr size_t WS_WOUT = WS_WUKV + (size_t)1024 * 512 * 2;
constexpr size_t WS_W1 = WS_WOUT + (size_t)DM * DM * 2;
constexpr size_t WS_W2 = WS_W1 + (size_t)DFF * DM * 2;
constexpr size_t WS_X = WS_W2 + (size_t)DM * DFF * 2;
constexpr size_t WS_H = WS_X + (size_t)T * DM * 4;
constexpr size_t WS_PROJ = WS_H + (size_t)T * DM * 2;
constexpr size_t WS_QA = WS_PROJ + (size_t)T * INW * 2;
constexpr size_t WS_KVA = WS_QA + (size_t)T * 768 * 2;
constexpr size_t WS_OAB = WS_KVA + (size_t)T * 1024 * 2;
constexpr size_t WS_OC = WS_OAB + (size_t)T * 1280 * 2;
constexpr size_t WS_LSE = WS_OC + (size_t)3 * T * 768 * 2;
constexpr size_t WS_XB1 = WS_LSE + (size_t)3 * T * 8 * 4;
constexpr size_t WS_XB2 = WS_XB1 + (size_t)T * DM * 2;
constexpr size_t WS_SS1 = WS_XB2 + (size_t)T * DM * 2;
constexpr size_t WS_SS2 = WS_SS1 + (size_t)T * 32 * 4;
constexpr size_t WS_WB1 = WS_SS2 + (size_t)T * 32 * 4;
constexpr size_t WBUF_BYTES = WS_X - WS_WIN;
constexpr size_t WS_END = WS_WB1 + WBUF_BYTES;
constexpr size_t WS_U = WS_PROJ;
static_assert(WS_U + (size_t)T * DFF * 2 <= WS_LSE, "u overlay");

constexpr int LDS_BYTES = 135168;

__device__ __forceinline__ unsigned cvtpk(float lo, float hi) { unsigned r; asm volatile("v_cvt_pk_bf16_f32 %0, %1, %2" : "=v"(r) : "v"(lo), "v"(hi)); return r; }
__device__ __forceinline__ float bflo(unsigned w) { return __uint_as_float(w << 16); }
__device__ __forceinline__ float bfhi(unsigned w) { return __uint_as_float(w & 0xffff0000u); }
__device__ __forceinline__ float bf2f(unsigned short u) { return __uint_as_float((unsigned)u << 16); }
__device__ __forceinline__ unsigned short f2bf(float f) { unsigned u = __float_as_uint(f); return (unsigned short)((u + 0x7fffu + ((u >> 16) & 1u)) >> 16); }
__device__ __forceinline__ float wave_sum(float v) {
#pragma unroll
    for (int o = 1; o < 64; o <<= 1) v += __shfl_xor(v, o);
    return v;
}
#define LDS_WAIT() asm volatile("s_waitcnt lgkmcnt(0)" ::: "memory")

namespace pg8 {
constexpr int BM = 256, BK = 64, HALF = 128, HTB = HALF * BK * 2, NXCD = 8, WGM = 4;
__host__ __device__ __forceinline__ int lds_byte(int r, int c) { const int st = (r >> 4) * 2 + (c >> 5), rr = r & 15, cc = c & 31, ob = rr * 64 + cc * 2; return st * 1024 + (ob ^ (((ob >> 9) & 1) << 5)); }
__host__ __device__ __forceinline__ void stage_rc(int b, int& R, int& C) { const int st = b / 1024, sb = b % 1024, swz = sb ^ (((sb >> 9) & 1) << 5); R = (st >> 1) * 16 + swz / 64; C = (st & 1) * 32 + (swz % 64) / 2; }
__host__ __device__ __forceinline__ int perm32(int rho) { const int n = rho >> 4, i = rho & 15; return 8 * (i >> 2) + 4 * n + (i & 3); }

struct Unit { int pm, pn; };
struct Gemm { const bf16_t* A; const bf16_t* Bt; int M, N, K, lda; };

struct StaticOrder {
    int nM, nN, nwg, G, c;
    __device__ void init(int M, int N, int G_, int c_) { nM = M / BM; nN = N / BM; nwg = nM * nN; G = G_; c = c_; }
    __device__ bool next(int i, Unit& u) const {
        const long L = (long)i * G + c; if (L >= nwg) return false;
        int wgid = (int)L; { const int q = nwg / NXCD, r = nwg % NXCD, xcd = wgid % NXCD, off = wgid / NXCD; wgid = (xcd < r ? xcd * (q + 1) : r * (q + 1) + (xcd - r) * q) + off; }
        const int nig = WGM * nN, gid = wgid / nig, fm = gid * WGM, gsz = (nM - fm) < WGM ? (nM - fm) : WGM;
        u.pm = fm + ((wgid % nig) % gsz); u.pn = (wgid % nig) / gsz; return true;
    }
};

template <int ACT  > struct EpiBf16 {
    static constexpr bool PERM = true;
    bf16_t* O; int ldc;
    __device__ __forceinline__ void operator()(const f32x4 (&acc)[2][2][4][2], const Unit& u, int wr, int wc, int fr, int fq) const {
        const int row0 = u.pm * BM + wr * 64 + fr; const int col0 = u.pn * BM + wc * 32 + 8 * fq;
#pragma unroll
        for (int ai = 0; ai < 2; ++ai)
#pragma unroll
            for (int m = 0; m < 4; ++m) { bf16_t* rowp = O + (size_t)(row0 + ai * HALF + m * 16) * ldc + col0;
#pragma unroll
                for (int bj = 0; bj < 2; ++bj) { f32x4 v0 = acc[ai][bj][m][0], v1 = acc[ai][bj][m][1];
                    if (ACT == 1) {
#pragma unroll
                        for (int j = 0; j < 4; ++j) { float a = fmaxf(v0[j], 0.f), b = fmaxf(v1[j], 0.f); v0[j] = a * a; v1[j] = b * b; } }
                    u32x4 w; w.x = cvtpk(v0[0], v0[1]); w.y = cvtpk(v0[2], v0[3]); w.z = cvtpk(v1[0], v1[1]); w.w = cvtpk(v1[2], v1[3]);
                    *(u32x4*)(rowp + bj * HALF) = w; } }
    }
};
__device__ __forceinline__ void rtab_update(LAS float* rtab, const float* ss, int pm) {
    __builtin_amdgcn_s_barrier();
    int tid = threadIdx.x; asm volatile("" : "+v"(tid));
    const int r = tid >> 1, hlf = tid & 1; const f32x4* sp = (const f32x4*)(ss + (size_t)(pm * BM + r) * 32) + 4 * hlf;
    const f32x4 a = sp[0], b = sp[1], c = sp[2], d = sp[3];
    float h = (((a[0] + a[1]) + (a[2] + a[3])) + ((b[0] + b[1]) + (b[2] + b[3]))) + (((c[0] + c[1]) + (c[2] + c[3])) + ((d[0] + d[1]) + (d[2] + d[3])));
    h += __shfl_xor(h, 1);
    if (hlf == 0) rtab[1 + r] = rsqrtf(h * (1.0f / DM) + EPS);
    if (tid == 0) ((LAS int*)rtab)[0] = pm;
    asm volatile("s_waitcnt lgkmcnt(0)" ::: "memory");
    __builtin_amdgcn_s_barrier();
}
template <int ACT> struct EpiBf16SS {
    static constexpr bool PERM = true;
    bf16_t* O; int ldc; const float* ss; LAS float* rtab;
    __device__ __forceinline__ void operator()(const f32x4 (&acc)[2][2][4][2], const Unit& u, int wr, int wc, int fr, int fq) const {
        const int row0 = u.pm * BM + wr * 64 + fr; const int col0 = u.pn * BM + wc * 32 + 8 * fq;
        if (((LAS const int*)rtab)[0] != u.pm) rtab_update(rtab, ss, u.pm);
#pragma unroll
        for (int ai = 0; ai < 2; ++ai)
#pragma unroll
            for (int m = 0; m < 4; ++m) { const int row = row0 + ai * HALF + m * 16; bf16_t* rowp = O + (size_t)row * ldc + col0;
                const float rs = rtab[1 + ai * HALF + wr * 64 + m * 16 + fr];
#pragma unroll
                for (int bj = 0; bj < 2; ++bj) { f32x4 v0 = acc[ai][bj][m][0] * rs, v1 = acc[ai][bj][m][1] * rs;
                    if (ACT == 1) {
#pragma unroll
                        for (int j = 0; j < 4; ++j) { float a = fmaxf(v0[j], 0.f), b = fmaxf(v1[j], 0.f); v0[j] = a * a; v1[j] = b * b; } }
                    u32x4 w; w.x = cvtpk(v0[0], v0[1]); w.y = cvtpk(v0[2], v0[3]); w.z = cvtpk(v1[0], v1[1]); w.w = cvtpk(v1[2], v1[3]);
                    if (ACT == 1) __builtin_nontemporal_store(w, (u32x4*)(rowp + bj * HALF)); else *(u32x4*)(rowp + bj * HALF) = w; } }
    }
};
struct EpiResidualSS {
    static constexpr bool PERM = true;
    const float* src; float* dst; bf16_t* XB; float* ss;
    __device__ __forceinline__ void operator()(const f32x4 (&acc)[2][2][4][2], const Unit& u, int wr, int wc, int fr, int fq) const {
        const int row0 = u.pm * BM + wr * 64 + fr; const int col0 = u.pn * BM + wc * 32 + 8 * fq;
#pragma unroll
        for (int ai = 0; ai < 2; ++ai)
#pragma unroll
            for (int m = 0; m < 4; ++m) { const int row = row0 + ai * HALF + m * 16; const size_t off = (size_t)row * DM + col0; float s = 0.f;
#pragma unroll
                for (int bj = 0; bj < 2; ++bj) { const f32x4 a = *(const f32x4*)(src + off + bj * HALF) + acc[ai][bj][m][0], b = *(const f32x4*)(src + off + bj * HALF + 4) + acc[ai][bj][m][1];
                    *(f32x4*)(dst + off + bj * HALF) = a; *(f32x4*)(dst + off + bj * HALF + 4) = b;
                    u32x4 w; w.x = cvtpk(a[0], a[1]); w.y = cvtpk(a[2], a[3]); w.z = cvtpk(b[0], b[1]); w.w = cvtpk(b[2], b[3]);
                    *(u32x4*)(XB + off + bj * HALF) = w;
                    s += (a[0] * a[0] + a[1] * a[1]) + (a[2] * a[2] + a[3] * a[3]) + (b[0] * b[0] + b[1] * b[1]) + (b[2] * b[2] + b[3] * b[3]); }
                s += __shfl_xor(s, 16); s += __shfl_xor(s, 32);
                if (fq == 0) ss[(size_t)row * 32 + u.pn * 4 + wc] = s; }
    }
};
template <int LDC, int NCOLS> struct EpiRowScale {
    static constexpr bool PERM = true; static constexpr int ldc = LDC, lda = INW, ncols = NCOLS;
    bf16_t* O; const bf16_t* A; LAS float* rsum;
    __device__ __forceinline__ void operator()(const f32x4 (&acc)[2][2][4][2], const Unit& u, int wr, int wc, int fr, int fq) const {
        const int row0 = u.pm * BM + wr * 64 + fr; const int col0 = u.pn * BM + wc * 32 + 8 * fq;
        const float inv_n = 1.0f / (float)ncols;
#pragma unroll
        for (int ai = 0; ai < 2; ++ai) { const int lr = ai * HALF + wr * 64 + wc * 16 + fr;
            const bf16_t* rp = A + (size_t)(u.pm * BM + lr) * lda; float s = 0.f;
#pragma unroll 7
            for (int c = fq * 8; c < ncols; c += 32) { const u32x4 v = *(const u32x4*)(rp + c);
                float a;
                a = bflo(v.x); s += a * a; a = bfhi(v.x); s += a * a; a = bflo(v.y); s += a * a; a = bfhi(v.y); s += a * a;
                a = bflo(v.z); s += a * a; a = bfhi(v.z); s += a * a; a = bflo(v.w); s += a * a; a = bfhi(v.w); s += a * a; }
            s += __shfl_xor(s, 16); s += __shfl_xor(s, 32);
            if (fq == 0) rsum[lr] = rsqrtf(s * inv_n + EPS); }
        asm volatile("s_waitcnt lgkmcnt(0)" ::: "memory");
        __builtin_amdgcn_s_barrier();
#pragma unroll
        for (int ai = 0; ai < 2; ++ai)
#pragma unroll
            for (int m = 0; m < 4; ++m) { const int lr = ai * HALF + wr * 64 + m * 16 + fr; const float rs = rsum[lr];
                bf16_t* rowp = O + (size_t)(u.pm * BM + lr) * ldc + col0;
#pragma unroll
                for (int bj = 0; bj < 2; ++bj) { const f32x4 v0 = acc[ai][bj][m][0] * rs, v1 = acc[ai][bj][m][1] * rs;
                    u32x4 w; w.x = cvtpk(v0[0], v0[1]); w.y = cvtpk(v0[2], v0[3]); w.z = cvtpk(v1[0], v1[1]); w.w = cvtpk(v1[2], v1[3]);
                    *(u32x4*)(rowp + bj * HALF) = w; } }
        asm volatile("s_waitcnt lgkmcnt(0)" ::: "memory");
        __builtin_amdgcn_s_barrier();
        (void)row0;
    }
};
struct EpiResidual {
    static constexpr bool PERM = true;
    const float* src; float* dst; int ld;
    __device__ __forceinline__ void operator()(const f32x4 (&acc)[2][2][4][2], const Unit& u, int wr, int wc, int fr, int fq) const {
        const int row0 = u.pm * BM + wr * 64 + fr; const int col0 = u.pn * BM + wc * 32 + 8 * fq;
#pragma unroll
        for (int ai = 0; ai < 2; ++ai)
#pragma unroll
            for (int m = 0; m < 4; ++m) { const size_t off = (size_t)(row0 + ai * HALF + m * 16) * ld + col0;
#pragma unroll
                for (int bj = 0; bj < 2; ++bj) { const f32x4 a = *(const f32x4*)(src + off + bj * HALF), b = *(const f32x4*)(src + off + bj * HALF + 4);
                    *(f32x4*)(dst + off + bj * HALF) = a + acc[ai][bj][m][0]; *(f32x4*)(dst + off + bj * HALF + 4) = b + acc[ai][bj][m][1]; } }
    }
};

template <class Epi, class Sched>
__device__ __forceinline__ void gemm_phase(LAS unsigned char* lds, const Gemm g, const Sched& S, const Epi& E) {
    int tid_ = threadIdx.x; asm volatile("" : "+v"(tid_));
    const int tid = tid_, wid = __builtin_amdgcn_readfirstlane(tid >> 6), lane = tid & 63, wr = wid >> 2, wc = wid & 3, fr = lane & 15, fq = lane >> 4;
    const int K = g.K, nt = K / BK, lda = g.lda;
    unsigned voffA[2], voffB[2];
#pragma unroll
    for (int i = 0; i < 2; ++i) { int R, C; stage_rc(tid * 16 + i * 8192, R, C); const int Rb = Epi::PERM ? ((R & ~31) + perm32(R & 31)) : R;
        voffA[i] = (unsigned)(R * lda + C) * 2u; voffB[i] = (unsigned)(Rb * K + C) * 2u; }
    const size_t kstep = (size_t)(BK * 2);
    const size_t hstepA = (size_t)HALF * lda * 2, hstepB = (size_t)HALF * K * 2;
    const size_t tstepA = 2 * hstepA, tstepB = 2 * hstepB;
    const unsigned ldsw = (unsigned)wid * 1024u;
    const int aoff = lds_byte(wr * 64 + fr, fq * 8), boff = lds_byte(wc * 32 + fr, fq * 8);
#define PG8_SA(b, h) (((b) * 2 + (h)) * HTB)
#define PG8_SB(b, h) ((4 + (b) * 2 + (h)) * HTB)
#define PG8_STAGE(bufoff, gbase, voff) do { _Pragma("unroll") for (int _i = 0; _i < 2; ++_i) \
        __builtin_amdgcn_global_load_lds((const unsigned*)((const char*)(gbase) + (voff)[_i]), (LAS unsigned*)(lds + (bufoff) + ldsw + _i * 8192), 16, 0, 0); } while (0)
#define PG8_LDA(dst, b, h) do { _Pragma("unroll") for (int m = 0; m < 4; ++m) _Pragma("unroll") for (int k = 0; k < 2; ++k) dst[m][k] = *(const LAS bf16x8*)(lds + PG8_SA(b, h) + aoff + m * 2048 + k * 1024); } while (0)
#define PG8_LDB(dst, b, h) do { _Pragma("unroll") for (int n = 0; n < 2; ++n) _Pragma("unroll") for (int k = 0; k < 2; ++k) dst[n][k] = *(const LAS bf16x8*)(lds + PG8_SB(b, h) + boff + n * 2048 + k * 1024); } while (0)
#define PG8_MMA(ai, bj, At, Bt) do { __builtin_amdgcn_s_setprio(1); _Pragma("unroll") for (int m = 0; m < 4; ++m) _Pragma("unroll") for (int n = 0; n < 2; ++n) _Pragma("unroll") for (int k = 0; k < 2; ++k) \
        acc[ai][bj][m][n] = __builtin_amdgcn_mfma_f32_16x16x32_bf16(Bt[n][k], At[m][k], acc[ai][bj][m][n], 0, 0, 0); __builtin_amdgcn_s_setprio(0); } while (0)
#define PG8_WAIT_V(n) asm volatile("s_waitcnt vmcnt(" #n ")" ::: "memory")
#define PG8_WAIT_L(n) asm volatile("s_waitcnt lgkmcnt(" #n ")" ::: "memory")
#define PG8_BAR __builtin_amdgcn_s_barrier()
#define PG8_SCHED __builtin_amdgcn_sched_barrier(0)
    Unit cur, nxt; int ui = 0;
    if (!S.next(0, cur)) return;
    f32x4 acc[2][2][4][2];
#pragma unroll
    for (int a = 0; a < 2; ++a)
#pragma unroll
        for (int b = 0; b < 2; ++b)
#pragma unroll
            for (int m = 0; m < 4; ++m)
#pragma unroll
                for (int n = 0; n < 2; ++n) acc[a][b][m][n] = (f32x4){0.f, 0.f, 0.f, 0.f};
    bf16x8 At[4][2], B0[2][2], B1[2][2];
    const char* cA = (const char*)g.A + (size_t)cur.pm * tstepA; const char* cB = (const char*)g.Bt + (size_t)cur.pn * tstepB;
    PG8_STAGE(PG8_SB(0, 0), cB, voffB); PG8_STAGE(PG8_SB(0, 1), cB + hstepB, voffB); PG8_STAGE(PG8_SA(0, 0), cA, voffA); PG8_STAGE(PG8_SA(0, 1), cA + hstepA, voffA);
    if (wr == 1) PG8_BAR;
    PG8_WAIT_V(2); PG8_BAR;
    PG8_STAGE(PG8_SB(1, 0), cB + kstep, voffB); PG8_STAGE(PG8_SA(1, 0), cA + kstep, voffA); PG8_STAGE(PG8_SB(1, 1), cB + hstepB + kstep, voffB);
    PG8_WAIT_V(6); PG8_BAR;
    for (;;) {
        const bool has_next = S.next(ui + 1, nxt);
        const char* nA = has_next ? (const char*)g.A + (size_t)nxt.pm * tstepA : cA; const char* nB = has_next ? (const char*)g.Bt + (size_t)nxt.pn * tstepB : cB;
        for (int t = 0; t < nt; t += 2) {
            const bool last = (t == nt - 2);
            const char* a1 = cA + (size_t)(t + 1) * kstep;
            const char* a2 = last ? nA : cA + (size_t)(t + 2) * kstep; const char* b2 = last ? nB : cB + (size_t)(t + 2) * kstep;
            const char* a3 = a2 + kstep; const char* b3 = b2 + kstep;
            PG8_LDB(B0, 0, 0); PG8_LDB(B1, 0, 1); PG8_SCHED; PG8_LDA(At, 0, 0); PG8_STAGE(PG8_SA(1, 1), a1 + hstepA, voffA);
            PG8_WAIT_V(8); PG8_WAIT_L(0); PG8_BAR; PG8_MMA(0, 0, At, B0); PG8_MMA(0, 1, At, B1); PG8_BAR; PG8_SCHED;
            PG8_LDA(At, 0, 1); PG8_STAGE(PG8_SB(0, 0), b2, voffB); PG8_STAGE(PG8_SB(0, 1), b2 + hstepB, voffB); PG8_STAGE(PG8_SA(0, 0), a2, voffA);
            PG8_WAIT_V(8); PG8_WAIT_L(0); PG8_BAR; PG8_MMA(1, 0, At, B0); PG8_MMA(1, 1, At, B1); PG8_BAR; PG8_SCHED;
            PG8_LDB(B0, 1, 0); PG8_LDB(B1, 1, 1); PG8_SCHED; PG8_LDA(At, 1, 0); PG8_STAGE(PG8_SA(0, 1), a2 + hstepA, voffA);
            PG8_WAIT_V(8); PG8_WAIT_L(0); PG8_BAR; PG8_MMA(0, 0, At, B0); PG8_MMA(0, 1, At, B1); PG8_BAR; PG8_SCHED;
            PG8_LDA(At, 1, 1); PG8_STAGE(PG8_SB(1, 0), b3, voffB); PG8_STAGE(PG8_SB(1, 1), b3 + hstepB, voffB); PG8_STAGE(PG8_SA(1, 0), a3, voffA);
            PG8_WAIT_V(8); PG8_WAIT_L(0); PG8_BAR; PG8_MMA(1, 0, At, B0); PG8_MMA(1, 1, At, B1); PG8_BAR; PG8_SCHED;
        }
        if (wr == 0) PG8_BAR;
        E(acc, cur, wr, wc, fr, fq);
        if (!has_next) break;
#pragma unroll
        for (int a = 0; a < 2; ++a)
#pragma unroll
            for (int b = 0; b < 2; ++b)
#pragma unroll
                for (int m = 0; m < 4; ++m)
#pragma unroll
                    for (int n = 0; n < 2; ++n) acc[a][b][m][n] = (f32x4){0.f, 0.f, 0.f, 0.f};
        cur = nxt; cA = nA; cB = nB; ++ui;
        if (wr == 1) PG8_BAR;
    }
    PG8_WAIT_V(0);
    PG8_BAR;
#undef PG8_SA
#undef PG8_SB
#undef PG8_STAGE
#undef PG8_LDA
#undef PG8_LDB
#undef PG8_MMA
#undef PG8_WAIT_V
#undef PG8_WAIT_L
#undef PG8_BAR
#undef PG8_SCHED
}
}

__device__ __forceinline__ int crow(int r, int hi) { return (r & 3) + 8 * (r >> 2) + 4 * hi; }
__device__ __forceinline__ int v_st(int k, int c) { const int kk = (k & ~0xC) | ((k & 4) << 1) | ((k & 8) >> 1); return ((kk >> 3) * 4 + (c >> 5)) * 512 + ((kk & 7) * 32 + (c & 31)) * 2; }
__device__ __forceinline__ int v_rd_base(int lane) { return ((lane & 3) << 3) | (((lane >> 2) & 3) << 6) | (((lane >> 4) & 1) << 5) | (((lane >> 5) & 1) << 8); }
constexpr int v_rd_off(int d0, int ks, int half) { return d0 * 512 + ks * 4096 + half * 2048; }
template <int OFF> __device__ __forceinline__ s16x4 tr_read(int vb) {
    s16x4 r; asm volatile("ds_read_b64_tr_b16 %0, %1 offset:%2" : "=&v"(r) : "v"(vb), "i"(OFF) : "memory"); return r;
}
template <int D0> __device__ __forceinline__ void pv_one(f32x16& od, int vb, bf16x8 pa0, bf16x8 pa1, bf16x8 pa2, bf16x8 pa3) {
    const s16x4 l0 = tr_read<v_rd_off(D0, 0, 0)>(vb), h0 = tr_read<v_rd_off(D0, 0, 1)>(vb), l1 = tr_read<v_rd_off(D0, 1, 0)>(vb), h1 = tr_read<v_rd_off(D0, 1, 1)>(vb);
    const s16x4 l2 = tr_read<v_rd_off(D0, 2, 0)>(vb), h2 = tr_read<v_rd_off(D0, 2, 1)>(vb), l3 = tr_read<v_rd_off(D0, 3, 0)>(vb), h3 = tr_read<v_rd_off(D0, 3, 1)>(vb);
    asm volatile("s_waitcnt lgkmcnt(0)" ::: "memory"); __builtin_amdgcn_sched_barrier(0);
#define PK(L, H) (bf16x8){L[0], L[1], L[2], L[3], H[0], H[1], H[2], H[3]}
    od = __builtin_amdgcn_mfma_f32_32x32x16_bf16(pa0, PK(l0, h0), od, 0, 0, 0);
    od = __builtin_amdgcn_mfma_f32_32x32x16_bf16(pa1, PK(l1, h1), od, 0, 0, 0);
    od = __builtin_amdgcn_mfma_f32_32x32x16_bf16(pa2, PK(l2, h2), od, 0, 0, 0);
    od = __builtin_amdgcn_mfma_f32_32x32x16_bf16(pa3, PK(l3, h3), od, 0, 0, 0);
#undef PK
}

template <int DK, int MODE>
__device__ __forceinline__ void attn_unit(LAS unsigned char* lds,
        const bf16_t* __restrict__ Q, long ldq, const bf16_t* __restrict__ K, long ldk, const bf16_t* __restrict__ K2, long ldk2,
        const bf16_t* __restrict__ V, long ldv, bf16_t* __restrict__ O, long ldo, float* __restrict__ LSE, long ldlse,
        const f32x2* __restrict__ tabA, int qpos0, int qpstride, int kt_begin, int kt_end, int kbase, int q0sub, float C, float scale) {
    constexpr int ND = DK / 16, KROW = DK * 2, KB = 64 * KROW, NKC = (DK == 192) ? 3 : 2;
    int tid_ = threadIdx.x; asm volatile("" : "+v"(tid_));
    const int tid = tid_, wid = tid >> 6, lane = tid & 63, r32 = lane & 31, hi = lane >> 5;
    LAS unsigned char* Kl = lds; LAS unsigned char* Vl = lds + KB;
    LAS float* wsf = (LAS float*)(lds + KB + 16384) + wid * 64; LAS float* li_l = wsf; LAS float* al_l = wsf + 32;
    float m_reg = -1e30f, l_reg = 0.f; f32x16 o[4];
#pragma unroll
    for (int d = 0; d < 4; ++d)
#pragma unroll
        for (int r = 0; r < 16; ++r) o[d][r] = 0.f;
    bf16x8 qr[ND];
    { const bf16_t* Qw = Q + (size_t)(wid * 32 + r32) * ldq + hi * 8;
#pragma unroll
      for (int d0 = 0; d0 < ND; ++d0) qr[d0] = *(const bf16x8*)(Qw + d0 * 16); }
    if (MODE == 0) {
        const f32x2* tb = tabA + (size_t)(qpos0 + wid * 32 + r32) * 32 + hi * 8;
#pragma unroll
        for (int dd = 0; dd < 2; ++dd) {
            bf16x8 a = qr[8 + dd], b = qr[10 + dd], na, nb;
#pragma unroll
            for (int j = 0; j < 8; ++j) { const f32x2 cs = tb[dd * 16 + j]; const float x1 = bf2f((unsigned short)a[j]), x2 = bf2f((unsigned short)b[j]);
                na[j] = (short)f2bf(x1 * cs.x - x2 * cs.y); nb[j] = (short)f2bf(x1 * cs.y + x2 * cs.x); }
            qr[8 + dd] = na; qr[10 + dd] = nb;
        }
    }
    if (MODE == 2) {
        const f32x2* tb = tabA + (size_t)(qpos0 + (wid * 32 + r32) * qpstride) * 64 + hi * 8;
#pragma unroll
        for (int dd = 0; dd < 4; ++dd) { const bf16x8 xa = qr[dd], xb = qr[dd + 4]; bf16x8 na, nb;
#pragma unroll
            for (int j = 0; j < 8; ++j) { const f32x2 cs = tb[dd * 16 + j]; const float x1 = bf2f((unsigned short)xa[j]), x2 = bf2f((unsigned short)xb[j]);
                na[j] = (short)f2bf(x1 * cs.x - x2 * cs.y); nb[j] = (short)f2bf(x1 * cs.y + x2 * cs.x); }
            qr[dd] = na; qr[dd + 4] = nb; }
    }
    const int sr = tid >> 4, sc = (tid & 15) * 8;
    const int vst0 = v_st(sr, sc), vst1 = v_st(32 + sr, sc);
    int krow[NKC], kch[NKC], klds[NKC];
#pragma unroll
    for (int i = 0; i < NKC; ++i) {
        if (DK == 192) { const int id = tid + 512 * i; krow[i] = id / 24; kch[i] = id % 24; }
        else { krow[i] = sr + 32 * i; kch[i] = tid & 15; }
        klds[i] = krow[i] * KROW + ((kch[i] * 16) ^ ((krow[i] & 7) << 4));
    }
    const int vb = (int)(uintptr_t)Vl + v_rd_base(lane);
    bf16x8 kreg[NKC], vreg[2];
#define ALOAD(k0) do { _Pragma("unroll") for (int i = 0; i < NKC; ++i) { \
        if (DK == 192 && kch[i] >= 16) kreg[i] = *(const bf16x8*)(K2 + (size_t)((k0) + krow[i]) * ldk2 + (kch[i] - 16) * 8); \
        else kreg[i] = *(const bf16x8*)(K + (size_t)((k0) + krow[i]) * ldk + kch[i] * 8); } \
        vreg[0] = *(const bf16x8*)(V + (size_t)((k0) + sr) * ldv + sc); vreg[1] = *(const bf16x8*)(V + (size_t)((k0) + 32 + sr) * ldv + sc); } while (0)
    ALOAD(kbase + 64 * kt_begin);
    const int wq0 = q0sub + wid * 32;
    for (int kt = kt_begin; kt < kt_end; ++kt) {
        const int k0 = kbase + 64 * kt;
        __syncthreads();
#pragma unroll
        for (int i = 0; i < NKC; ++i) *(LAS bf16x8*)(Kl + klds[i]) = kreg[i];
        *(LAS bf16x8*)(Vl + vst0) = vreg[0]; *(LAS bf16x8*)(Vl + vst1) = vreg[1];
        __syncthreads();
        if (kt + 1 < kt_end) ALOAD(k0 + 64);
        bool part = true;
        if (MODE == 2) part = (k0 <= wq0 + 31 + 64) && (k0 + 63 >= wq0 - 64);
        if (part) {
            f32x16 p0, p1;
#pragma unroll
            for (int r = 0; r < 16; ++r) { p0[r] = 0.f; p1[r] = 0.f; }
#pragma unroll
            for (int d0 = 0; d0 < ND; ++d0) { const int cb = (d0 * 16 + hi * 8) * 2; const int off = r32 * KROW + (cb ^ ((r32 & 7) << 4));
                const bf16x8 b0 = *(const LAS bf16x8*)(Kl + off); const bf16x8 b1 = *(const LAS bf16x8*)(Kl + off + 32 * KROW);
                p0 = __builtin_amdgcn_mfma_f32_32x32x16_bf16(b0, qr[d0], p0, 0, 0, 0);
                p1 = __builtin_amdgcn_mfma_f32_32x32x16_bf16(b1, qr[d0], p1, 0, 0, 0); }
            if (MODE == 2) { const int kb = k0 - (wq0 + r32);
#pragma unroll
                for (int r = 0; r < 16; ++r) { const int d = kb + crow(r, hi); if (d > 64 || d < -64) p0[r] = -INFINITY; const int d1 = d + 32; if (d1 > 64 || d1 < -64) p1[r] = -INFINITY; } }
            float pmax = p0[0];
#pragma unroll
            for (int r = 1; r < 16; ++r) pmax = fmaxf(pmax, p0[r]);
#pragma unroll
            for (int r = 0; r < 16; ++r) pmax = fmaxf(pmax, p1[r]);
            { auto rr = __builtin_amdgcn_permlane32_swap(__float_as_uint(pmax), __float_as_uint(pmax), false, false);
              pmax = fmaxf(__uint_as_float(rr[0]), __uint_as_float(rr[1])); }
            const float mn = fmaxf(m_reg, pmax); const float alpha = __builtin_amdgcn_exp2f((m_reg - mn) * C); m_reg = mn;
            const float mnC = -mn * C;
#pragma unroll
            for (int r = 0; r < 16; ++r) { p0[r] = __builtin_amdgcn_exp2f(fmaf(p0[r], C, mnC)); p1[r] = __builtin_amdgcn_exp2f(fmaf(p1[r], C, mnC)); }
            float ps = 0.f;
#pragma unroll
            for (int r = 0; r < 16; ++r) ps += p0[r];
#pragma unroll
            for (int r = 0; r < 16; ++r) ps += p1[r];
            { auto rr = __builtin_amdgcn_permlane32_swap(__float_as_uint(ps), __float_as_uint(ps), false, false);
              ps = __uint_as_float(rr[0]) + __uint_as_float(rr[1]); }
            l_reg = l_reg * alpha + ps;
            bf16x8 pa0, pa1, pa2, pa3;
#define PK4(P, BASE, OUT) do { unsigned a0 = cvtpk(P[BASE + 0], P[BASE + 1]), a1 = cvtpk(P[BASE + 2], P[BASE + 3]);   \
            unsigned b0_ = cvtpk(P[BASE + 4], P[BASE + 5]), b1_ = cvtpk(P[BASE + 6], P[BASE + 7]);                              \
            auto r0 = __builtin_amdgcn_permlane32_swap(a0, b0_, false, false); auto r1 = __builtin_amdgcn_permlane32_swap(a1, b1_, false, false); \
            u32x4 w = {r0[0], r1[0], r0[1], r1[1]}; OUT = *reinterpret_cast<bf16x8*>(&w); } while (0)
            PK4(p0, 0, pa0); PK4(p0, 8, pa1); PK4(p1, 0, pa2); PK4(p1, 8, pa3);
#undef PK4
            if (__any(alpha < 1.f)) { if (hi == 0) al_l[r32] = alpha; LDS_WAIT();
#pragma unroll
                for (int r = 0; r < 16; ++r) { const float a = al_l[crow(r, hi)];
#pragma unroll
                    for (int d = 0; d < 4; ++d) o[d][r] *= a; }
                LDS_WAIT(); }
            pv_one<0>(o[0], vb, pa0, pa1, pa2, pa3); pv_one<1>(o[1], vb, pa0, pa1, pa2, pa3); pv_one<2>(o[2], vb, pa0, pa1, pa2, pa3); pv_one<3>(o[3], vb, pa0, pa1, pa2, pa3);
        }
    }
#undef ALOAD
    if (hi == 0) li_l[r32] = l_reg; LDS_WAIT();
    bf16_t* Ow = O + (size_t)(wid * 32) * ldo;
#pragma unroll
    for (int r = 0; r < 16; ++r) { const int orow = crow(r, hi); const float rl = 1.0f / li_l[orow];
#pragma unroll
        for (int d0 = 0; d0 < 4; ++d0) Ow[(size_t)orow * ldo + d0 * 32 + r32] = f2bf(o[d0][r] * rl); }
    if (MODE == 2) { if (hi == 0) LSE[(size_t)(wid * 32 + r32) * ldlse] = m_reg * scale + logf(l_reg); }
    LDS_WAIT();
}


template <int MODE> __device__ __forceinline__ void partialSM(f32x16& p0, f32x16& p1, float& m_reg, float& mn, float& alpha) {
    constexpr float SCALE = (MODE == 0) ? 0.07216878364870322f : 0.08838834764831845f, C = SCALE * LOG2E, THR = 8.f;
    float pmax = p0[0];
#pragma unroll
    for (int r = 1; r < 16; ++r) pmax = fmaxf(pmax, p0[r]);
#pragma unroll
    for (int r = 0; r < 16; ++r) pmax = fmaxf(pmax, p1[r]);
    { auto rr = __builtin_amdgcn_permlane32_swap(__float_as_uint(pmax), __float_as_uint(pmax), false, false);
      pmax = fmaxf(__uint_as_float(rr[0]), __uint_as_float(rr[1])); }
    if (__builtin_expect(__all(pmax - m_reg <= THR / SCALE), 1)) { mn = m_reg; alpha = 1.f; }
    else { mn = fmaxf(m_reg, pmax); alpha = __builtin_amdgcn_exp2f((m_reg - mn) * C); m_reg = mn; }
    const float mnC = -mn * C;
#pragma unroll
    for (int r = 0; r < 16; ++r) p0[r] = fmaf(p0[r], C, mnC);
#pragma unroll
    for (int r = 0; r < 16; ++r) p1[r] = fmaf(p1[r], C, mnC);
#pragma unroll
    for (int r = 0; r < 16; ++r) p0[r] = __builtin_amdgcn_exp2f(p0[r]);
}
__device__ __forceinline__ void finishSM(f32x16& p0, f32x16& p1, float alpha, float& l_reg, bf16x8& pa0, bf16x8& pa1, bf16x8& pa2, bf16x8& pa3) {
#pragma unroll
    for (int r = 0; r < 16; ++r) p1[r] = __builtin_amdgcn_exp2f(p1[r]);
    float ps = 0.f;
#pragma unroll
    for (int r = 0; r < 16; ++r) ps += p0[r];
#pragma unroll
    for (int r = 0; r < 16; ++r) ps += p1[r];
    { auto rr = __builtin_amdgcn_permlane32_swap(__float_as_uint(ps), __float_as_uint(ps), false, false);
      ps = __uint_as_float(rr[0]) + __uint_as_float(rr[1]); }
    l_reg = l_reg * alpha + ps;
#define PK4(P, BASE, OUT) do { unsigned a0 = cvtpk(P[BASE + 0], P[BASE + 1]), a1 = cvtpk(P[BASE + 2], P[BASE + 3]);   \
    unsigned b0_ = cvtpk(P[BASE + 4], P[BASE + 5]), b1_ = cvtpk(P[BASE + 6], P[BASE + 7]);                              \
    auto r0 = __builtin_amdgcn_permlane32_swap(a0, b0_, false, false); auto r1 = __builtin_amdgcn_permlane32_swap(a1, b1_, false, false); \
    u32x4 w = {r0[0], r1[0], r0[1], r1[1]}; OUT = *reinterpret_cast<bf16x8*>(&w); } while (0)
    PK4(p0, 0, pa0); PK4(p0, 8, pa1); PK4(p1, 0, pa2); PK4(p1, 8, pa3);
#undef PK4
}
template <int DK> __device__ __forceinline__ void qkt(f32x16& p0, f32x16& p1, LAS const unsigned char* Ks, const bf16x8* qr, LAS const unsigned char* qpe, int r32, int hi) {
    constexpr int ND = DK / 16, KROW = DK * 2;
#pragma unroll
    for (int r = 0; r < 16; ++r) { p0[r] = 0.f; p1[r] = 0.f; }
#pragma unroll
    for (int d0 = 0; d0 < ND; ++d0) { const int cb = (d0 * 16 + hi * 8) * 2; const int off = r32 * KROW + (cb ^ ((r32 & 7) << 4));
        const bf16x8 b0 = *(const LAS bf16x8*)(Ks + off); const bf16x8 b1 = *(const LAS bf16x8*)(Ks + off + 32 * KROW);
        bf16x8 q; if (d0 < 8) q = qr[d0]; else q = *(const LAS bf16x8*)(qpe + (d0 - 8) * 1024);
        p0 = __builtin_amdgcn_mfma_f32_32x32x16_bf16(b0, q, p0, 0, 0, 0);
        p1 = __builtin_amdgcn_mfma_f32_32x32x16_bf16(b1, q, p1, 0, 0, 0); }
}
__device__ __forceinline__ void pv_d0(f32x16* o, int vb, bf16x8 pa0, bf16x8 pa1, bf16x8 pa2, bf16x8 pa3) {
    pv_one<0>(o[0], vb, pa0, pa1, pa2, pa3); pv_one<1>(o[1], vb, pa0, pa1, pa2, pa3); pv_one<2>(o[2], vb, pa0, pa1, pa2, pa3); pv_one<3>(o[3], vb, pa0, pa1, pa2, pa3);
}
#define SBAR() __builtin_amdgcn_sched_barrier(0)
template <int DK, int MODE>
__device__ __forceinline__ void attn_pipe(LAS unsigned char* lds,
        const bf16_t* __restrict__ Q, const bf16_t* __restrict__ K, const bf16_t* __restrict__ K2,
        bf16_t* __restrict__ O, const f32x2* __restrict__ tabA, int qpos0, const float* __restrict__ gq) {
    constexpr int ldq = (MODE == 0) ? 768 : INW, ldk = (MODE == 0) ? 1024 : INW, ldk2 = INW, ldo = 1280, VOFF = (MODE == 0) ? 128 : 256;
    constexpr int ND = DK / 16, KROW = DK * 2, SHM_K = 64 * KROW, SHM_V = 16384, NKC = (DK == 192) ? 3 : 2, NT = SEQ / 64;
    int tid_ = threadIdx.x; asm volatile("" : "+v"(tid_));
    const int tid = tid_, wid = tid >> 6, lane = tid & 63, r32 = lane & 31, hi = lane >> 5;
    LAS unsigned char* V_lds = lds; LAS unsigned char* K_lds = lds + 2 * SHM_V;
    LAS float* wsf = (LAS float*)(lds + 2 * SHM_V + 2 * SHM_K) + wid * 64; LAS float* li_l = wsf; LAS float* al_l = wsf + 32;
    float m_reg = -1e30f, l_reg = 0.f; f32x16 o[4];
#pragma unroll
    for (int d = 0; d < 4; ++d)
#pragma unroll
        for (int r = 0; r < 16; ++r) o[d][r] = 0.f;
    bf16x8 qr[8];
    LAS unsigned char* qpe = lds + 2 * SHM_V + 2 * SHM_K + 2048 + wid * 4096 + lane * 16;
    const bf16_t* Qw = Q + (size_t)(wid * 32 + r32) * ldq + hi * 8;
#pragma unroll
    for (int d0 = 0; d0 < 8; ++d0) qr[d0] = *(const bf16x8*)(Qw + d0 * 16);
    if (MODE == 0) {
        const f32x2* tb = tabA + (size_t)(qpos0 + wid * 32 + r32) * 32 + hi * 8;
#pragma unroll
        for (int dd = 0; dd < 2; ++dd) {
            const bf16x8 a = *(const bf16x8*)(Qw + (8 + dd) * 16), b = *(const bf16x8*)(Qw + (10 + dd) * 16); bf16x8 na, nb;
#pragma unroll
            for (int j = 0; j < 8; ++j) { const f32x2 cs = tb[dd * 16 + j]; const float x1 = bf2f((unsigned short)a[j]), x2 = bf2f((unsigned short)b[j]);
                na[j] = (short)f2bf(x1 * cs.x - x2 * cs.y); nb[j] = (short)f2bf(x1 * cs.y + x2 * cs.x); }
            *(LAS bf16x8*)(qpe + dd * 1024) = na; *(LAS bf16x8*)(qpe + (2 + dd) * 1024) = nb;
        }
    }
    if (MODE == 1) {
        float ssq = 0.f;
#pragma unroll
        for (int d0 = 0; d0 < 8; ++d0)
#pragma unroll
            for (int j = 0; j < 8; ++j) { const float x = bf2f((unsigned short)qr[d0][j]); ssq += x * x; }
        ssq += __shfl_xor(ssq, 32);
        const float rq = rsqrtf(ssq * (1.0f / 128.0f) + EPS);
        const int pos = qpos0 + wid * 32 + r32;
#pragma unroll
        for (int hf = 0; hf < 2; ++hf) {
            const f32x2* tb = tabA + (size_t)(hf == 0 ? (pos >> 6) : (pos & 63)) * 32 + hi * 8;
#pragma unroll
            for (int dd = 0; dd < 2; ++dd) { const int da = hf * 4 + dd, db = da + 2;
                const bf16x8 xa = qr[da], xb = qr[db]; bf16x8 na, nb;
                const float* g1 = gq + da * 16 + hi * 8; const float* g2 = gq + db * 16 + hi * 8;
#pragma unroll
                for (int j = 0; j < 8; ++j) { const f32x2 cs = tb[dd * 16 + j];
                    const float y1 = bf2f((unsigned short)xa[j]) * rq * g1[j], y2 = bf2f((unsigned short)xb[j]) * rq * g2[j];
                    na[j] = (short)f2bf(y1 * cs.x - y2 * cs.y); nb[j] = (short)f2bf(y1 * cs.y + y2 * cs.x); }
                qr[da] = na; qr[db] = nb; }
        }
    }
    const int sr = tid >> 4, sc = (tid & 15) * 8;
    const int vst0 = v_st(sr, sc), vst1 = v_st(32 + sr, sc);
    const int klds0 = sr * KROW + ((sc * 2) ^ ((sr & 7) << 4));
    const int klds2 = (tid >> 3) * KROW + ((256 + (tid & 7) * 16) ^ (((tid >> 3) & 7) << 4));
    const int vb0 = (int)(uintptr_t)V_lds + v_rd_base(lane);
    const bf16_t* kp = K + (size_t)sr * ldk + sc;
    const bf16_t* kp2 = (DK == 192) ? (K2 + (size_t)(tid >> 3) * ldk2 + (tid & 7) * 8) : nullptr;
    bf16x8 kreg[NKC], vreg[2];
#define SLOAD(k0) do { const bf16_t* a0_ = kp + (size_t)(k0) * ldk; kreg[0] = *(const bf16x8*)a0_; vreg[0] = *(const bf16x8*)(a0_ + VOFF); \
        kreg[1] = *(const bf16x8*)(a0_ + 32 * ldk); vreg[1] = *(const bf16x8*)(a0_ + 32 * ldk + VOFF); \
        if (DK == 192) kreg[NKC - 1] = *(const bf16x8*)(kp2 + (size_t)(k0) * ldk2); } while (0)
#define SWRITE(b) do { *(LAS bf16x8*)(K_lds + (b) * SHM_K + klds0) = kreg[0]; *(LAS bf16x8*)(K_lds + (b) * SHM_K + klds0 + 32 * KROW) = kreg[1]; \
        if (DK == 192) *(LAS bf16x8*)(K_lds + (b) * SHM_K + klds2) = kreg[NKC - 1]; \
        *(LAS bf16x8*)(V_lds + (b) * SHM_V + vst0) = vreg[0]; *(LAS bf16x8*)(V_lds + (b) * SHM_V + vst1) = vreg[1]; } while (0)
#define SWAIT() asm volatile("s_waitcnt vmcnt(0)" ::: "memory")
#define RESC(a) do { if (__any((a) < 1.f)) { if (hi == 0) al_l[r32] = (a); LDS_WAIT(); \
        _Pragma("unroll") for (int r = 0; r < 16; ++r) { const float a_ = al_l[crow(r, hi)]; _Pragma("unroll") for (int d = 0; d < 4; ++d) o[d][r] *= a_; } } } while (0)
    f32x16 pA0, pA1, pB0, pB1; float mnA, mnB, alA, alB; bf16x8 pa0, pa1, pa2, pa3;
    __syncthreads();
    SLOAD(0); SWAIT(); SWRITE(0); __syncthreads();
    qkt<DK>(pA0, pA1, K_lds, qr, qpe, r32, hi); partialSM<MODE>(pA0, pA1, m_reg, mnA, alA);
    SLOAD(64); SWAIT(); SWRITE(1); __syncthreads();
    for (int j = 1; j + 1 < NT; j += 2) {
        SBAR(); qkt<DK>(pB0, pB1, K_lds + SHM_K, qr, qpe, r32, hi);
        finishSM(pA0, pA1, alA, l_reg, pa0, pa1, pa2, pa3); SBAR();
        SLOAD((j + 1) * 64); SBAR();
        pv_d0(o, vb0, pa0, pa1, pa2, pa3); partialSM<MODE>(pB0, pB1, m_reg, mnB, alB);
        __syncthreads(); SWAIT(); SWRITE(0);
        RESC(alB); __syncthreads();
        SBAR(); qkt<DK>(pA0, pA1, K_lds, qr, qpe, r32, hi);
        finishSM(pB0, pB1, alB, l_reg, pa0, pa1, pa2, pa3); SBAR();
        SLOAD((j + 2) * 64); SBAR();
        pv_d0(o, vb0 + SHM_V, pa0, pa1, pa2, pa3); partialSM<MODE>(pA0, pA1, m_reg, mnA, alA);
        __syncthreads(); SWAIT(); SWRITE(1);
        RESC(alA); __syncthreads();
    }
    SBAR(); qkt<DK>(pB0, pB1, K_lds + SHM_K, qr, qpe, r32, hi);
    finishSM(pA0, pA1, alA, l_reg, pa0, pa1, pa2, pa3); SBAR();
    pv_d0(o, vb0, pa0, pa1, pa2, pa3); partialSM<MODE>(pB0, pB1, m_reg, mnB, alB);
    __syncthreads(); RESC(alB);
    finishSM(pB0, pB1, alB, l_reg, pa0, pa1, pa2, pa3); SBAR();
    pv_d0(o, vb0 + SHM_V, pa0, pa1, pa2, pa3);
    if (hi == 0) li_l[r32] = l_reg; LDS_WAIT();
    bf16_t* Ow = O + (size_t)(wid * 32) * ldo;
#pragma unroll
    for (int r = 0; r < 16; ++r) { const int orow = crow(r, hi); const float rl = __builtin_amdgcn_rcpf(li_l[orow]);
#pragma unroll
        for (int d0 = 0; d0 < 4; ++d0) Ow[(size_t)orow * ldo + d0 * 32 + r32] = f2bf(o[d0][r] * rl); }
    LDS_WAIT();
#undef SLOAD
#undef SWRITE
#undef SWAIT
#undef RESC
}

__device__ __forceinline__ void transpose_item(const float* __restrict__ W, int Ksrc, int N, const float* __restrict__ gk, bf16_t* __restrict__ WT, int Kdst, LAS float* scr, int item, int lane) {
    const int nblk = N / 32, kb = item / nblk, nb = item % nblk, k0 = 64 * kb, n0 = 32 * nb;
    float tv[32];
#pragma unroll
    for (int i = 0; i < 32; ++i) { const int k = k0 + 2 * i + (lane >> 5); tv[i] = (k < Ksrc) ? W[(size_t)k * N + n0 + (lane & 31)] : 0.f; }
#pragma unroll
    for (int i = 0; i < 32; ++i) scr[(2 * i + (lane >> 5)) * 33 + (lane & 31)] = tv[i];
    LDS_WAIT();
    const int c = lane & 7;
    f32x4 ga = (f32x4){1.f, 1.f, 1.f, 1.f}, gb = ga;
    if (gk && k0 + 8 * c < Ksrc) { ga = *(const f32x4*)(gk + k0 + 8 * c); gb = *(const f32x4*)(gk + k0 + 8 * c + 4); }
#pragma unroll
    for (int j = 0; j < 4; ++j) { const int n = (lane >> 3) + 8 * j; const LAS float* s = scr + (8 * c) * 33 + n;
        u32x4 o; o.x = cvtpk(s[0 * 33] * ga[0], s[1 * 33] * ga[1]); o.y = cvtpk(s[2 * 33] * ga[2], s[3 * 33] * ga[3]); o.z = cvtpk(s[4 * 33] * gb[0], s[5 * 33] * gb[1]); o.w = cvtpk(s[6 * 33] * gb[2], s[7 * 33] * gb[3]);
        *(u32x4*)(WT + (size_t)(n0 + n) * Kdst + k0 + 8 * c) = o; }
    LDS_WAIT();
}
__device__ __forceinline__ void rms_row_bf16(const float* __restrict__ xrow, const float* __restrict__ g, bf16_t* __restrict__ orow, int lane) {
    const f32x4* xr = (const f32x4*)xrow + lane; const f32x4* gr = (const f32x4*)g + lane;
    f32x4 v[8]; float s = 0.f;
#pragma unroll
    for (int j = 0; j < 8; ++j) { v[j] = xr[64 * j]; s += (v[j].x * v[j].x + v[j].y * v[j].y) + (v[j].z * v[j].z + v[j].w * v[j].w); }
    const float r = rsqrtf(wave_sum(s) * (1.0f / DM) + EPS);
    u32x2* o8 = (u32x2*)orow + lane;
#pragma unroll
    for (int j = 0; j < 8; ++j) { const f32x4 gg = gr[64 * j]; u32x2 w; w.x = cvtpk(v[j].x * r * gg.x, v[j].y * r * gg.y); w.y = cvtpk(v[j].z * r * gg.z, v[j].w * r * gg.w); o8[64 * j] = w; }
}
__device__ __forceinline__ void xb_row(const float* __restrict__ xrow, bf16_t* __restrict__ orow, float* __restrict__ ssp, int lane) {
    const f32x4* xr = (const f32x4*)xrow + lane; f32x4 v[8]; float s = 0.f;
#pragma unroll
    for (int j = 0; j < 8; ++j) { v[j] = xr[64 * j]; s += (v[j].x * v[j].x + v[j].y * v[j].y) + (v[j].z * v[j].z + v[j].w * v[j].w); }
    s = wave_sum(s);
    u32x2* o8 = (u32x2*)orow + lane;
#pragma unroll
    for (int j = 0; j < 8; ++j) { u32x2 w; w.x = cvtpk(v[j].x, v[j].y); w.y = cvtpk(v[j].z, v[j].w); o8[64 * j] = w; }
    if (lane < 32) ssp[lane] = (lane == 0) ? s : 0.f;
}
__device__ __forceinline__ void rms_row_f32(const float* __restrict__ xrow, const float* __restrict__ g, float* __restrict__ orow, int lane) {
    const f32x4* xr = (const f32x4*)xrow + lane; const f32x4* gr = (const f32x4*)g + lane;
    f32x4 v[8]; float s = 0.f;
#pragma unroll
    for (int j = 0; j < 8; ++j) { v[j] = xr[64 * j]; s += (v[j].x * v[j].x + v[j].y * v[j].y) + (v[j].z * v[j].z + v[j].w * v[j].w); }
    const float r = rsqrtf(wave_sum(s) * (1.0f / DM) + EPS);
    f32x4* o = (f32x4*)orow + lane;
#pragma unroll
    for (int j = 0; j < 8; ++j) { const f32x4 gg = gr[64 * j]; o[64 * j] = v[j] * r * gg; }
}
__device__ __forceinline__ void sincos_rev(float ang, float& c, float& s) {
    const double rev = (double)ang * 0.15915494309189535; const double fr = rev - rint(rev); const float f = (float)fr;
    s = __builtin_amdgcn_sinf(f); c = __builtin_amdgcn_cosf(f);
}

#ifndef PH_MASK
#define PH_MASK 0xFFFF
#endif
#define PH(k) ((PH_MASK >> (k)) & 1)
#ifndef REP_ATTN
#define REP_ATTN 1
#endif
#ifndef REP_FF1
#define REP_FF1 1
#endif
#ifndef REP_P1
#define REP_P1 1
#endif
#ifndef REP_P2
#define REP_P2 1
#endif
#ifndef REP_C
#define REP_C 1
#endif
#ifndef REP_ROW
#define REP_ROW 1
#endif
#ifndef REP_SYNC
#define REP_SYNC 0
#endif
#ifndef REP_P3G
#define REP_P3G 1
#endif
#ifndef REP_P5
#define REP_P5 1
#endif
#ifndef REP_P6X
#define REP_P6X 0
#endif
#ifndef REP_FF2X
#define REP_FF2X 0
#endif


constexpr int I_IN = (DM / 64) * (INW / 32), I_UQ = (512 / 64) * (768 / 32), I_UKV = (512 / 64) * (1024 / 32), I_OUT = (DM / 64) * (DM / 32),
              I_1 = (DM / 64) * (DFF / 32), I_2 = (DFF / 64) * (DM / 32), NIT = I_IN + I_UQ + I_UKV + I_OUT + I_1 + I_2;
static_assert(NIT % 8 == 0, "block items of 8 wave items");
#define XB_TMO      128
#define XB_XCNT(j)  (256  + 64 * (j))
#define XB_XSUB(j)  (1280 + 64 * (j))
#define XB_XGEN(j)  (2304 + 64 * (j))
#define XB_TOP      3328
#define XB_TOPGEN   3392
#define XCD_BAR_WORDS 3456
#define XB_SPIN_CAP (1u << 18)
constexpr int CW_BAR = 512;
static_assert((CW_BAR + XCD_BAR_WORDS) * 4 <= 16384, "control region");
__device__ __forceinline__ unsigned xb_ld(unsigned* p)              { return __hip_atomic_load(p, __ATOMIC_RELAXED, __HIP_MEMORY_SCOPE_AGENT); }
__device__ __forceinline__ unsigned xb_add(unsigned* p, unsigned v) { return __hip_atomic_fetch_add(p, v, __ATOMIC_RELAXED, __HIP_MEMORY_SCOPE_AGENT); }
__device__ __forceinline__ unsigned xb_xcc_id() { return (unsigned)__builtin_amdgcn_s_getreg((3 << 11) | 20) & 0xFu; }
#define XB_SPIN(cond, bar) do { unsigned _sp = 0; while (cond) { __builtin_amdgcn_s_sleep(1); \
    if ((++_sp & 255u) == 0u) { if (xb_ld(&(bar)[XB_TMO])) break; if (_sp > XB_SPIN_CAP) { atomicAdd(&(bar)[XB_TMO], 1u); break; } } } } while (0)
__device__ __forceinline__ void xcd_barrier_complete(unsigned* bar, unsigned x, unsigned& nloc, unsigned& nx) {
    const unsigned G = gridDim.x;
    unsigned sum, cnt, mine, sp = 0u;
    for (;;) {
        sum = 0u; cnt = 0u; mine = 0u;
#pragma unroll
        for (unsigned j = 0; j < 16; ++j) { const unsigned c = xb_ld(&bar[XB_XCNT(j)]); sum += c; cnt += (c > 0u) ? 1u : 0u; mine = (j == x) ? c : mine; }
        if (sum == G) break;
        __builtin_amdgcn_s_sleep(1);
        if ((++sp & 255u) == 0u) { if (xb_ld(&bar[XB_TMO])) break; if (sp > XB_SPIN_CAP) { atomicAdd(&bar[XB_TMO], 1u); break; } }
    }
    nloc = mine > 0u ? mine : 1u; nx = cnt > 0u ? cnt : 1u;
}
__device__ __forceinline__ void xcd_barrier(unsigned* bar, volatile LAS unsigned* st) {
    asm volatile("s_waitcnt vmcnt(0)" ::: "memory");
    __syncthreads();
    if (threadIdx.x == 0) {
        __builtin_amdgcn_s_waitcnt(0);
        const unsigned x = xb_xcc_id();
        unsigned nloc = st[0], nx = st[1];
        if (nloc == 0u) { xcd_barrier_complete(bar, x, nloc, nx); st[0] = nloc; st[1] = nx; }
        const unsigned old = xb_add(&bar[XB_XSUB(x)], 1u);
        const unsigned gen = old / nloc;
        if (old + 1u == (gen + 1u) * nloc) {
            __builtin_amdgcn_fence(__ATOMIC_RELEASE, "agent");
            asm volatile("s_waitcnt vmcnt(0)" ::: "memory");
            const unsigned og = xb_add(&bar[XB_TOP], 1u);
            const unsigned tg = og / nx;
            if (og + 1u == (tg + 1u) * nx) xb_add(&bar[XB_TOPGEN], 1u);
            else XB_SPIN(xb_ld(&bar[XB_TOPGEN]) == tg, bar);
            __builtin_amdgcn_fence(__ATOMIC_ACQUIRE, "agent");
            xb_add(&bar[XB_XGEN(x)], 1u);
            asm volatile("s_waitcnt vmcnt(0)" ::: "memory");
        } else {
            XB_SPIN(xb_ld(&bar[XB_XGEN(x)]) == gen, bar);
            __builtin_amdgcn_fence(__ATOMIC_ACQUIRE, "agent");
            asm volatile("s_waitcnt vmcnt(0)" ::: "memory");
        }
    }
    __syncthreads();
}

struct Params { const float* in[15]; float* out; unsigned char* ws; };
#define KAS __attribute__((address_space(4)))
__device__ __forceinline__ void conv_item(int r, int layer, const KAS Params* pp, unsigned char* wb, LAS float* scr, int lane) {
    const size_t L = (size_t)layer;
    if (r < I_IN) { transpose_item(pp->in[2] + L * DM * INW, DM, INW, pp->in[1] + L * DM, (bf16_t*)(wb + (WS_WIN - WS_WIN)), DM, scr, r, lane); return; } r -= I_IN;
    if (r < I_UQ) { transpose_item(pp->in[4] + L * 448 * 768, 448, 768, pp->in[3] + L * 448, (bf16_t*)(wb + (WS_WUQ - WS_WIN)), 512, scr, r, lane); return; } r -= I_UQ;
    if (r < I_UKV) { transpose_item(pp->in[6] + L * 512 * 1024, 512, 1024, pp->in[5] + L * 512, (bf16_t*)(wb + (WS_WUKV - WS_WIN)), 512, scr, r, lane); return; } r -= I_UKV;
    if (r < I_OUT) { transpose_item(pp->in[10] + L * DM * DM, DM, DM, nullptr, (bf16_t*)(wb + (WS_WOUT - WS_WIN)), DM, scr, r, lane); return; } r -= I_OUT;
    if (r < I_1) { transpose_item(pp->in[12] + L * DM * DFF, DM, DFF, pp->in[11] + L * DM, (bf16_t*)(wb + (WS_W1 - WS_WIN)), DM, scr, r, lane); return; } r -= I_1;
    transpose_item(pp->in[13] + L * DFF * DM, DFF, DM, nullptr, (bf16_t*)(wb + (WS_W2 - WS_WIN)), DFF, scr, r, lane);
}


__global__ void __launch_bounds__(512, 2) mega_fwd(Params p) {
    extern __shared__ __attribute__((aligned(16))) unsigned char smem[];
    LAS unsigned char* lds = (LAS unsigned char*)smem;
    cg::grid_group grid = cg::this_grid();
    const int tid0 = threadIdx.x, wid = __builtin_amdgcn_readfirstlane(tid0 >> 6);
#define FRESH() int tid = tid0; asm volatile("" : "+v"(tid)); const int lane = tid & 63; (void)lane
    const int G = gridDim.x, gw = blockIdx.x * 8 + wid, NGW = G * 8;
#define WSPTRS() WSPTRS_L(0)
#define WSPTRS_L(LL) const KAS Params* ppw = (const KAS Params*)__builtin_amdgcn_kernarg_segment_ptr(); asm volatile("" : "+s"(ppw)); unsigned char* ws = ppw->ws; \
    unsigned* ctl = (unsigned*)(ws + WS_CTL); f32x2* tabC = (f32x2*)(ws + WS_TABC); f32x2* tabA = (f32x2*)(ws + WS_TABA); \
    unsigned char* wb_ = ws + (((LL) & 1) ? WS_WB1 : WS_WIN); \
    bf16_t* Win = (bf16_t*)(wb_); bf16_t* Wuq = (bf16_t*)(wb_ + (WS_WUQ - WS_WIN)); bf16_t* Wukv = (bf16_t*)(wb_ + (WS_WUKV - WS_WIN)); \
    bf16_t* Wout = (bf16_t*)(wb_ + (WS_WOUT - WS_WIN)); bf16_t* W1 = (bf16_t*)(wb_ + (WS_W1 - WS_WIN)); bf16_t* W2 = (bf16_t*)(wb_ + (WS_W2 - WS_WIN)); \
    float* X = (float*)(ws + WS_X); bf16_t* H = (bf16_t*)(ws + WS_H); bf16_t* PROJ = (bf16_t*)(ws + WS_PROJ); \
    bf16_t* QA = (bf16_t*)(ws + WS_QA); bf16_t* KVA = (bf16_t*)(ws + WS_KVA); bf16_t* OAB = (bf16_t*)(ws + WS_OAB); \
    bf16_t* OC = (bf16_t*)(ws + WS_OC); float* LSEB = (float*)(ws + WS_LSE); bf16_t* U = (bf16_t*)(ws + WS_U); \
    bf16_t* XB1 = (bf16_t*)(ws + WS_XB1); bf16_t* XB2 = (bf16_t*)(ws + WS_XB2); float* SS1 = (float*)(ws + WS_SS1); float* SS2 = (float*)(ws + WS_SS2); \
    (void)ctl; (void)tabC; (void)tabA; (void)Win; (void)Wuq; (void)Wukv; (void)Wout; (void)W1; (void)W2; (void)X; (void)H; (void)PROJ; (void)QA; (void)KVA; (void)OAB; (void)OC; (void)LSEB; (void)U; (void)XB1; (void)XB2; (void)SS1; (void)SS2
#define LPTRS() int ll = l; asm volatile("" : "+s"(ll)); const KAS Params* ppl = (const KAS Params*)__builtin_amdgcn_kernarg_segment_ptr(); asm volatile("" : "+s"(ppl)); \
    const float* x_in = ppl->in[0]; const float* ln1_g = ppl->in[1] + (size_t)ll * DM; const float* w_in = ppl->in[2] + (size_t)ll * DM * INW; \
    const float* g_q_a = ppl->in[3] + (size_t)ll * 448; const float* w_uq = ppl->in[4] + (size_t)ll * 448 * 768; const float* g_kv_a = ppl->in[5] + (size_t)ll * 512; \
    const float* w_ukv = ppl->in[6] + (size_t)ll * 512 * 1024; const float* g_qn_b = ppl->in[7] + (size_t)ll * 128; const float* g_kn_b = ppl->in[8] + (size_t)ll * 128; \
    const float* g_out = ppl->in[9] + (size_t)ll * DM; const float* w_out = ppl->in[10] + (size_t)ll * DM * DM; const float* ln2_g = ppl->in[11] + (size_t)ll * DM; \
    const float* w_ff1 = ppl->in[12] + (size_t)ll * DM * DFF; const float* w_ff2 = ppl->in[13] + (size_t)ll * DFF * DM; \
    (void)x_in; (void)ln1_g; (void)w_in; (void)g_q_a; (void)w_uq; (void)g_kv_a; (void)w_ukv; (void)g_qn_b; (void)g_kn_b; (void)g_out; (void)w_out; (void)ln2_g; (void)w_ff1; (void)w_ff2
    volatile LAS unsigned* xst = (volatile LAS unsigned*)(lds + 131072 + 16);
    if (tid0 == 0) { xst[0] = 0u; xst[1] = 0u; }
    __syncthreads();
    { WSPTRS(); if (blockIdx.x == 0) for (int i = tid0; i < 4096; i += 512) ctl[i] = 0u; }
#define GSYNC() do { WSPTRS(); xcd_barrier(ctl + CW_BAR, xst); } while (0)
    {
        FRESH(); WSPTRS();
        const int NT_ = G * 512;
        const float l2t = 13.287712379549449f;
        for (int base = blockIdx.x * 512; base < 4096 * 64; base += NT_) { const int i = base + tid; const int pos = i >> 6, k = i & 63; const float inv = exp2f(-((float)(2 * k) / 128.0f) * l2t);
            const float ang = (float)pos * inv; float c, s; sincos_rev(ang, c, s); tabC[i] = (f32x2){c, s}; }
        for (int base = blockIdx.x * 512; base < 4096 * 32; base += NT_) { const int i = base + tid; const int pos = i >> 5, k = i & 31; const float inv = exp2f(-((float)(2 * k) / 64.0f) * l2t);
            const float ang = (float)pos * inv; float c, s; sincos_rev(ang, c, s); tabA[i] = (f32x2){c, s}; }
    }

    for (int l = 0; l < DEPTH; ++l) {
        if (l == 0) {
            for (int rep = 0; rep < REP_P1; ++rep) {
                FRESH(); WSPTRS();
                LAS float* scr = (LAS float*)(lds + wid * 16384);
                for (int it = gw; it < NIT; it += NGW) conv_item(it, 0, ppw, ws + WS_WIN, scr, lane);
                for (int m = gw; m < T; m += NGW) xb_row(ppw->in[0] + (size_t)m * DM, XB1 + (size_t)m * DM, SS1 + (size_t)m * 32, lane);
            }
            grid.sync();
            { WSPTRS(); if (tid0 == 0) (void)xb_add(&ctl[CW_BAR + XB_XCNT(xb_xcc_id())], 1u); }
        }

        for (int rep = 0; rep < REP_P2; ++rep) {
            WSPTRS_L(l);
            pg8::Gemm g{XB1, Win, T, 4096, DM, DM}; pg8::StaticOrder S; S.init(T, 4096, G, (int)blockIdx.x);
            { LAS int* tg_ = (LAS int*)(lds + 131072 + 2048); if (tid0 == 0) *tg_ = -1; __syncthreads(); }
            pg8::EpiBf16SS<0> E{PROJ, INW, SS1, (LAS float*)(lds + 131072 + 2048)};
            pg8::gemm_phase(lds, g, S, E);
        }
        GSYNC();

        if (PH(3)) {
            FRESH(); WSPTRS_L(l); LPTRS();
            {
            const int G2 = G / 2, bx = (int)blockIdx.x, c1 = (bx < G2) ? bx : (1 << 20), c2 = (bx >= G2) ? bx - G2 : (1 << 20);
            { pg8::Gemm g{XB1, Win + (size_t)4096 * DM, T, 512, DM, DM}; pg8::StaticOrder S; S.init(T, 512, G2, c1);
              { LAS int* tg_ = (LAS int*)(lds + 131072 + 2048); if (tid0 == 0) *tg_ = -1; __syncthreads(); }
              pg8::EpiBf16SS<0> E{PROJ + 4096, INW, SS1, (LAS float*)(lds + 131072 + 2048)}; pg8::gemm_phase(lds, g, S, E); }
            { pg8::Gemm g{PROJ + C_CQ, Wuq, T, 768, 512, INW}; pg8::StaticOrder S; S.init(T, 768, G2, c2);
              pg8::EpiRowScale<768, 448> E{QA, PROJ + C_CQ, (LAS float*)(lds + 131072 + 64)}; pg8::gemm_phase(lds, g, S, E); }
            { pg8::Gemm g{PROJ + C_CKV, Wukv, T, 1024, 512, INW}; pg8::StaticOrder S; S.init(T, 1024, G2, c2);
              pg8::EpiRowScale<1024, 512> E{KVA, PROJ + C_CKV, (LAS float*)(lds + 131072 + 64)}; pg8::gemm_phase(lds, g, S, E); }
            }
            for (int rp = 0; rp < REP_ROW; ++rp) {
            bf16_t* rbase = (rp == 0) ? PROJ : XB1; const int rstride = (rp == 0) ? INW : 4096;
            const int e1 = (lane < 32) ? lane : lane + 32, e2 = e1 + 32;
            const float gk1 = g_kn_b[e1], gk2 = g_kn_b[e2];
            for (int t0 = gw; t0 < T; t0 += 2 * NGW) {
                float kx1[2], kx2[2], b1[2][2], b2[2][2], c1[2][6], c2[2][6]; f32x2 csb[2], csc[2], csa[2];
#pragma unroll
                for (int q = 0; q < 2; ++q) { const int t = t0 + q * NGW; const bf16_t* row = rbase + (size_t)t * rstride; const int pos = t & (SEQ - 1);
                    const f32x2* tA = tabA + (size_t)pos * 32; const f32x2* tC = tabC + (size_t)pos * 64;
                    const f32x2* tR = tabA + (size_t)(pos >> 6) * 32; const f32x2* tCl = tabA + (size_t)(pos & 63) * 32;
                    csb[q] = (lane < 32) ? tR[lane] : tCl[lane - 32]; csc[q] = tC[lane]; csa[q] = tA[lane & 31];
                    const bf16_t* kr = row + C_KR; kx1[q] = bf2f(kr[lane & 31]); kx2[q] = bf2f(kr[(lane & 31) + 32]);
#pragma unroll
                    for (int hh = 0; hh < 2; ++hh) { const bf16_t* hp = row + C_BK + hh * 128; b1[q][hh] = bf2f(hp[e1]); b2[q][hh] = bf2f(hp[e2]); }
#pragma unroll
                    for (int hh = 0; hh < 6; ++hh) { const bf16_t* hp = row + C_CK + hh * 128; c1[q][hh] = bf2f(hp[lane]); c2[q][hh] = bf2f(hp[lane + 64]); } }
#pragma unroll
                for (int q = 0; q < 2; ++q) { const int t = t0 + q * NGW; bf16_t* row = rbase + (size_t)t * rstride;
                    bf16_t* kr = row + C_KR;
                    if (lane < 32) { kr[lane] = f2bf(kx1[q] * csa[q].x - kx2[q] * csa[q].y); kr[lane + 32] = f2bf(kx1[q] * csa[q].y + kx2[q] * csa[q].x); }
#pragma unroll
                    for (int hh = 0; hh < 2; ++hh) { bf16_t* hp = row + C_BK + hh * 128;
                        const float r = rsqrtf(wave_sum(b1[q][hh] * b1[q][hh] + b2[q][hh] * b2[q][hh]) * (1.0f / 128.0f) + EPS);
                        const float y1 = b1[q][hh] * r * gk1, y2 = b2[q][hh] * r * gk2;
                        hp[e1] = f2bf(y1 * csb[q].x - y2 * csb[q].y); hp[e2] = f2bf(y1 * csb[q].y + y2 * csb[q].x); }
#pragma unroll
                    for (int hh = 0; hh < 6; ++hh) { bf16_t* hp = row + C_CK + hh * 128;
                        hp[lane] = f2bf(c1[q][hh] * csc[q].x - c2[q][hh] * csc[q].y); hp[lane + 64] = f2bf(c1[q][hh] * csc[q].y + c2[q][hh] * csc[q].x); } }
            }
            }
        }
        GSYNC();

        for (int rep = 0; rep < REP_ATTN; ++rep) {
            FRESH(); WSPTRS(); LPTRS();
            LAS int* slot = (LAS int*)(lds + 131072);
            for (;;) {
                __syncthreads();
                if (tid == 0) *slot = (int)atomicAdd(&ctl[l + 8 * rep], 1u);
                __syncthreads();
                const int u = *slot;
                if (u >= 1792) break;
                if (u < 256) {
                    const int b = u >> 6, h = (u >> 4) & 3, qb = u & 15; const size_t t0 = (size_t)b * SEQ;
                    attn_pipe<192, 0>(lds, QA + (t0 + qb * 256) * 768 + h * 192, KVA + t0 * 1024 + h * 256, PROJ + t0 * INW + C_KR,
                                      OAB + (t0 + qb * 256) * 1280 + h * 128, tabA, qb * 256, nullptr);
                } else if (u < 640) {
                    const int v = u - 256; const int b = v / 96, rem = v % 96, head = rem >> 4, qb = rem & 15, kvh = head / 3; const size_t t0 = (size_t)b * SEQ;
                    attn_pipe<128, 1>(lds, PROJ + (t0 + qb * 256) * INW + C_BQ + head * 128, PROJ + t0 * INW + C_BK + kvh * 128, nullptr,
                                      OAB + (t0 + qb * 256) * 1280 + 512 + head * 128, tabA, qb * 256, g_qn_b);
                } else {
                    const int v = u - 640; const int br = v / 384, rem = v % 384, b = rem / 96, h = (rem >> 4) % 6, u16 = rem & 15;
                    const int dil = (br == 0) ? 1 : (br == 1 ? 4 : 16); const int L = SEQ / dil, upr = 16 / dil, residue = u16 / upr, qb = u16 % upr, q0 = qb * 256;
                    const size_t tokb = (size_t)b * SEQ + residue; const int kbase = q0 - 64;
                    const int ktb = (kbase < 0) ? 1 : 0; int kte = (L - kbase) / 64; if (kte > 6) kte = 6;
                    for (int rc_ = 0; rc_ < REP_C; ++rc_)
                    attn_unit<128, 2>(lds, PROJ + (tokb + (size_t)q0 * dil) * INW + C_CQ3 + h * 128, (long)dil * INW, PROJ + tokb * INW + C_CK + h * 128, (long)dil * INW, nullptr, 0,
                                      PROJ + tokb * INW + C_CV + h * 128, (long)dil * INW, OC + ((size_t)br * T + tokb + (size_t)q0 * dil) * 768 + h * 128, (long)dil * 768,
                                      LSEB + ((size_t)br * T + tokb + (size_t)q0 * dil) * 8 + h, (long)dil * 8,
                                      tabC, q0 * dil + residue, dil, ktb, kte, kbase, q0, 0.08838834764831845f * LOG2E, 0.08838834764831845f);
                }
            }
        }
        if (l + 1 < DEPTH) {
            FRESH(); WSPTRS();
            LAS int* slot = (LAS int*)(lds + 131072);
            LAS float* scr = (LAS float*)(lds + wid * 16384);
            unsigned char* wbn = ws + (((l + 1) & 1) ? WS_WB1 : WS_WIN);
            for (;;) {
                __syncthreads();
                if (tid == 0) *slot = (int)atomicAdd(&ctl[16 + l], 1u);
                __syncthreads();
                const int bi = *slot;
                if (bi >= NIT / 8) break;
                conv_item(bi * 8 + wid, l + 1, ppw, wbn, scr, lane);
            }
        }
        GSYNC();

        for (int rep = 0; rep < REP_P5; ++rep) {
            FRESH(); WSPTRS(); LPTRS();
            for (int t0 = gw; t0 < T; t0 += 2 * NGW) {
                u32x2 ra[2][2], rb[2][3], rc[2][3][3]; float rl[2][3][3];
#pragma unroll
                for (int q = 0; q < 2; ++q) { const int t = t0 + q * NGW; const bf16_t* oab = OAB + (size_t)t * 1280;
#pragma unroll
                    for (int j = 0; j < 2; ++j) ra[q][j] = *(const u32x2*)(oab + (lane + 64 * j) * 4);
#pragma unroll
                    for (int j = 0; j < 3; ++j) rb[q][j] = *(const u32x2*)(oab + 512 + (lane + 64 * j) * 4);
#pragma unroll
                    for (int j = 0; j < 3; ++j) { const int ci = lane + 64 * j, col = ci * 4, head = ci >> 5;
#pragma unroll
                        for (int br = 0; br < 3; ++br) { rl[q][j][br] = LSEB[((size_t)br * T + t) * 8 + head]; rc[q][j][br] = *(const u32x2*)(OC + ((size_t)br * T + t) * 768 + col); } } }
#pragma unroll
                for (int q = 0; q < 2; ++q) { const int t = t0 + q * NGW; bf16_t* mx = H + (size_t)t * DM; const float* gr = g_out;
                    f32x4 va[2], vb_[3], vc[3]; float sa = 0.f, sb = 0.f, sc_ = 0.f;
#pragma unroll
                    for (int j = 0; j < 2; ++j) { const u32x2 w = ra[q][j]; va[j] = (f32x4){bflo(w.x), bfhi(w.x), bflo(w.y), bfhi(w.y)};
                        sa += (va[j].x * va[j].x + va[j].y * va[j].y) + (va[j].z * va[j].z + va[j].w * va[j].w); }
#pragma unroll
                    for (int j = 0; j < 3; ++j) { const u32x2 w = rb[q][j]; vb_[j] = (f32x4){bflo(w.x), bfhi(w.x), bflo(w.y), bfhi(w.y)};
                        sb += (vb_[j].x * vb_[j].x + vb_[j].y * vb_[j].y) + (vb_[j].z * vb_[j].z + vb_[j].w * vb_[j].w); }
#pragma unroll
                    for (int j = 0; j < 3; ++j) { const float l0 = rl[q][j][0], l1 = rl[q][j][1], l2 = rl[q][j][2];
                        const float mxl = fmaxf(l0, fmaxf(l1, l2)); float w0 = __expf(l0 - mxl), w1 = __expf(l1 - mxl), w2 = __expf(l2 - mxl);
                        const float inv = 1.0f / (w0 + w1 + w2); w0 *= inv; w1 *= inv; w2 *= inv;
                        const u32x2 a = rc[q][j][0], b = rc[q][j][1], c = rc[q][j][2];
                        vc[j].x = w0 * bflo(a.x) + w1 * bflo(b.x) + w2 * bflo(c.x); vc[j].y = w0 * bfhi(a.x) + w1 * bfhi(b.x) + w2 * bfhi(c.x);
                        vc[j].z = w0 * bflo(a.y) + w1 * bflo(b.y) + w2 * bflo(c.y); vc[j].w = w0 * bfhi(a.y) + w1 * bfhi(b.y) + w2 * bfhi(c.y);
                        sc_ += (vc[j].x * vc[j].x + vc[j].y * vc[j].y) + (vc[j].z * vc[j].z + vc[j].w * vc[j].w); }
                    const float ra_ = rsqrtf(wave_sum(sa) * (1.0f / 512.0f) + EPS), rb_ = rsqrtf(wave_sum(sb) * (1.0f / 768.0f) + EPS), rc_ = rsqrtf(wave_sum(sc_) * (1.0f / 768.0f) + EPS);
#pragma unroll
                    for (int j = 0; j < 2; ++j) { const int col = (lane + 64 * j) * 4; const f32x4 gg = *(const f32x4*)(gr + col); const f32x4 y = va[j] * ra_ * gg;
                        u32x2 w; w.x = cvtpk(y.x, y.y); w.y = cvtpk(y.z, y.w); *(u32x2*)(mx + col) = w; }
#pragma unroll
                    for (int j = 0; j < 3; ++j) { const int col = 512 + (lane + 64 * j) * 4; const f32x4 gg = *(const f32x4*)(gr + col); const f32x4 y = vb_[j] * rb_ * gg;
                        u32x2 w; w.x = cvtpk(y.x, y.y); w.y = cvtpk(y.z, y.w); *(u32x2*)(mx + col) = w; }
#pragma unroll
                    for (int j = 0; j < 3; ++j) { const int col = 1280 + (lane + 64 * j) * 4; const f32x4 gg = *(const f32x4*)(gr + col); const f32x4 y = vc[j] * rc_ * gg;
                        u32x2 w; w.x = cvtpk(y.x, y.y); w.y = cvtpk(y.z, y.w); *(u32x2*)(mx + col) = w; } }
            }
        }
        GSYNC();

        for (int rep = 0; rep < REP_SYNC; ++rep) GSYNC();
        for (int rep = 0; rep < REP_P6X; ++rep) {
            WSPTRS_L(l); pg8::Gemm g{H, Wout, T, DM, DM, DM}; pg8::StaticOrder S; S.init(T, DM, G, (int)blockIdx.x);
            pg8::EpiBf16<0> E{XB2, DM}; pg8::gemm_phase(lds, g, S, E);
        }
        if (PH(6)) {
            WSPTRS_L(l); LPTRS(); const float* xsrc = (l == 0) ? x_in : X;
            pg8::Gemm g{H, Wout, T, DM, DM, DM}; pg8::StaticOrder S; S.init(T, DM, G, (int)blockIdx.x);
            pg8::EpiResidualSS E{xsrc, X, XB2, SS2};
            pg8::gemm_phase(lds, g, S, E);
        }
        GSYNC();


        for (int rep = 0; rep < REP_FF1; ++rep) {
            WSPTRS_L(l);
            pg8::Gemm g{XB2, W1, T, DFF, DM, DM}; pg8::StaticOrder S; S.init(T, DFF, G, (int)blockIdx.x);
            { LAS int* tg_ = (LAS int*)(lds + 131072 + 2048); if (tid0 == 0) *tg_ = -1; __syncthreads(); }
            pg8::EpiBf16SS<1> E{U, DFF, SS2, (LAS float*)(lds + 131072 + 2048)};
            pg8::gemm_phase(lds, g, S, E);
        }
        GSYNC();

        for (int rep = 0; rep < REP_FF2X; ++rep) {
            WSPTRS_L(l); pg8::Gemm g{U, W2, T, DM, DFF, DFF}; pg8::StaticOrder S; S.init(T, DM, G, (int)blockIdx.x);
            pg8::EpiBf16<0> E{H, DM}; pg8::gemm_phase(lds, g, S, E);
        }
        if (PH(9)) {
            WSPTRS_L(l);
            pg8::Gemm g{U, W2, T, DM, DFF, DFF}; pg8::StaticOrder S; S.init(T, DM, G, (int)blockIdx.x);
            pg8::EpiResidualSS E{X, X, XB1, SS1};
            pg8::gemm_phase(lds, g, S, E);
        }
        GSYNC();
    }
    FRESH(); WSPTRS();
    for (int m = gw; m < T; m += NGW) rms_row_f32(X + (size_t)m * DM, ppw->in[14], ppw->out + (size_t)m * DM, lane);
}

extern "C" void kernel_launch(void* const* d_in, const int* in_sizes, int n_in, void* d_out, int out_size, void* d_ws, size_t ws_size, hipStream_t stream) {
    static int grid_blocks = 0;
    if (grid_blocks == 0) {
        if (n_in != 15 || out_size != T * DM || ws_size < WS_END) { fprintf(stderr, "kernel_launch: unexpected shapes (n_in %d out %d ws %zu need %zu)\n", n_in, out_size, ws_size, (size_t)WS_END); grid_blocks = -1; return; }
        int dev = 0, cus = 0, per_cu = 0;
        hipGetDevice(&dev);
        hipDeviceGetAttribute(&cus, hipDeviceAttributeMultiprocessorCount, dev);
        if (hipFuncSetAttribute((const void*)mega_fwd, hipFuncAttributeMaxDynamicSharedMemorySize, LDS_BYTES) != hipSuccess) { fprintf(stderr, "kernel_launch: hipFuncSetAttribute failed\n"); grid_blocks = -1; return; }
        if (hipOccupancyMaxActiveBlocksPerMultiprocessor(&per_cu, (const void*)mega_fwd, 512, LDS_BYTES) != hipSuccess || per_cu < 1) { fprintf(stderr, "kernel_launch: occupancy query gave %d\n", per_cu); per_cu = 1; }
        (void)hipGetLastError();
        grid_blocks = cus * per_cu;
    }
    if (grid_blocks < 0) return;
    Params p{};
    for (int i = 0; i < 15; ++i) p.in[i] = (const float*)d_in[i];
    p.out = (float*)d_out; p.ws = (unsigned char*)d_ws;
    void* args[] = {&p};
    hipError_t e = hipLaunchCooperativeKernel((void*)mega_fwd, dim3(grid_blocks), dim3(512), args, LDS_BYTES, stream);
    if (e != hipSuccess) fprintf(stderr, "cooperative launch failed: %s (grid %d)\n", hipGetErrorString(e), grid_blocks);
}
```

```cpp
#include <hip/hip_runtime.h>
#include <hip/hip_cooperative_groups.h>
#include <cstdio>
#include <cstdint>
namespace cg = cooperative_groups;

typedef unsigned short bf16_t;
typedef short bf16x8 __attribute__((ext_vector_type(8)));
typedef short s16x4 __attribute__((ext_vector_type(4)));
typedef float f32x4 __attribute__((ext_vector_type(4)));
typedef float f32x2 __attribute__((ext_vector_type(2)));
typedef float f32x16 __attribute__((ext_vector_type(16)));
typedef unsigned u32x4 __attribute__((ext_vector_type(4)));
typedef unsigned u32x2 __attribute__((ext_vector_type(2)));
#define LAS __attribute__((address_space(3)))

constexpr int NB = 4, SEQ = 4096, T = NB * SEQ, DM = 2048, INW = 4608, DFF = 8192, DEPTH = 4;
constexpr int C_CQ = 0, C_CKV = 448, C_KR = 960, C_BQ = 1024, C_BK = 1792, C_BV = 2048, C_CQ3 = 2304, C_CK = 3072, C_CV = 3840;
constexpr float EPS = 1e-6f;
constexpr float LOG2E = 1.4426950408889634f;

constexpr size_t al256(size_t x) { return (x + 255) / 256 * 256; }
constexpr size_t WS_CTL = 0;
constexpr size_t WS_TABC = 16384;
constexpr size_t WS_TABA = WS_TABC + (size_t)4096 * 64 * 8;
constexpr size_t WS_WIN = al256(WS_TABA + (size_t)4096 * 32 * 8);
constexpr size_t WS_WUQ = WS_WIN + (size_t)INW * DM * 2;
constexpr size_t WS_WUKV = WS_WUQ + (size_t)768 * 512 * 2;
constexpr size_t WS_WOUT = WS_WUKV + (size_t)1024 * 512 * 2;
constexpr size_t WS_W1 = WS_WOUT + (size_t)DM * DM * 2;
constexpr size_t WS_W2 = WS_W1 + (size_t)DFF * DM * 2;
constexpr size_t WS_X = WS_W2 + (size_t)DM * DFF * 2;
constexpr size_t WS_H = WS_X + (size_t)T * DM * 4;
constexpr size_t WS_PROJ = WS_H + (size_t)T * DM * 2;
constexpr size_t WS_QA = WS_PROJ + (size_t)T * INW * 2;
constexpr size_t WS_KVA = WS_QA + (size_t)T * 768 * 2;
constexpr size_t WS_OAB = WS_KVA + (size_t)T * 1024 * 2;
constexpr size_t WS_OC = WS_OAB + (size_t)T * 1280 * 2;
constexpr size_t WS_LSE = WS_OC + (size_t)3 * T * 768 * 2;
constexpr size_t WS_XB1 = WS_LSE + (size_t)3 * T * 8 * 4;
constexpr size_t WS_XB2 = WS_XB1 + (size_t)T * DM * 2;
constexpr size_t WS_SS1 = WS_XB2 + (size_t)T * DM * 2;
constexpr size_t WS_SS2 = WS_SS1 + (size_t)T * 32 * 4;
constexpr size_t WS_WB1 = WS_SS2 + (size_t)T * 32 * 4;
constexpr size_t WBUF_BYTES = WS_X - WS_WIN;
constexpr size_t WS_END = WS_WB1 + WBUF_BYTES;
constexpr size_t WS_U = WS_PROJ;
static_assert(WS_U + (size_t)T * DFF * 2 <= WS_LSE, "u overlay");

constexpr int LDS_BYTES = 135168;

__device__ __forceinline__ unsigned cvtpk(float lo, float hi) { unsigned r; asm volatile("v_cvt_pk_bf16_f32 %0, %1, %2" : "=v"(r) : "v"(lo), "v"(hi)); return r; }
__device__ __forceinline__ float bflo(unsigned w) { return __uint_as_float(w << 16); }
__device__ __forceinline__ float bfhi(unsigned w) { return __uint_as_float(w & 0xffff0000u); }
__device__ __forceinline__ float bf2f(unsigned short u) { return __uint_as_float((unsigned)u << 16); }
__device__ __forceinline__ unsigned short f2bf(float f) { unsigned u = __float_as_uint(f); return (unsigned short)((u + 0x7fffu + ((u >> 16) & 1u)) >> 16); }
__device__ __forceinline__ float wave_sum(float v) {
#pragma unroll
    for (int o = 1; o < 64; o <<= 1) v += __shfl_xor(v, o);
    return v;
}
#define LDS_WAIT() asm volatile("s_waitcnt lgkmcnt(0)" ::: "memory")

namespace pg8 {
constexpr int BM = 256, BK = 64, HALF = 128, HTB = HALF * BK * 2, NXCD = 8, WGM = 4;
__host__ __device__ __forceinline__ int lds_byte(int r, int c) { const int st = (r >> 4) * 2 + (c >> 5), rr = r & 15, cc = c & 31, ob = rr * 64 + cc * 2; return st * 1024 + (ob ^ (((ob >> 9) & 1) << 5)); }
__host__ __device__ __forceinline__ void stage_rc(int b, int& R, int& C) { const int st = b / 1024, sb = b % 1024, swz = sb ^ (((sb >> 9) & 1) << 5); R = (st >> 1) * 16 + swz / 64; C = (st & 1) * 32 + (swz % 64) / 2; }
__host__ __device__ __forceinline__ int perm32(int rho) { const int n = rho >> 4, i = rho & 15; return 8 * (i >> 2) + 4 * n + (i & 3); }

struct Unit { int pm, pn; };
struct Gemm { const bf16_t* A; const bf16_t* Bt; int M, N, K, lda; };

struct StaticOrder {
    int nM, nN, nwg, G, c, R;
    __device__ void init(int M, int N, int G_, int c_) { nM = M / BM; nN = N / BM; nwg = nM * nN; G = G_; c = c_; R = 0; }
    __device__ void reverse_rounds() { if (G > 0 && nwg % G == 0 && c < G) R = nwg / G; }
    __device__ bool next(int i, Unit& u) const {
        if (R > 0) { if (i >= R) return false; i = R - 1 - i; }
        const long L = (long)i * G + c; if (L >= nwg) return false;
        int wgid = (int)L; { const int q = nwg / NXCD, r = nwg % NXCD, xcd = wgid % NXCD, off = wgid / NXCD; wgid = (xcd < r ? xcd * (q + 1) : r * (q + 1) + (xcd - r) * q) + off; }
        const int nig = WGM * nN, gid = wgid / nig, fm = gid * WGM, gsz = (nM - fm) < WGM ? (nM - fm) : WGM;
        u.pm = fm + ((wgid % nig) % gsz); u.pn = (wgid % nig) / gsz; return true;
    }
};

template <int ACT  > struct EpiBf16 {
    static constexpr bool PERM = true;
    bf16_t* O; int ldc;
    __device__ __forceinline__ void operator()(const f32x4 (&acc)[2][2][4][2], const Unit& u, int wr, int wc, int fr, int fq) const {
        const int row0 = u.pm * BM + wr * 64 + fr; const int col0 = u.pn * BM + wc * 32 + 8 * fq;
#pragma unroll
        for (int ai = 0; ai < 2; ++ai)
#pragma unroll
            for (int m = 0; m < 4; ++m) { bf16_t* rowp = O + (size_t)(row0 + ai * HALF + m * 16) * ldc + col0;
#pragma unroll
                for (int bj = 0; bj < 2; ++bj) { f32x4 v0 = acc[ai][bj][m][0], v1 = acc[ai][bj][m][1];
                    if (ACT == 1) {
#pragma unroll
                        for (int j = 0; j < 4; ++j) { float a = fmaxf(v0[j], 0.f), b = fmaxf(v1[j], 0.f); v0[j] = a * a; v1[j] = b * b; } }
                    u32x4 w; w.x = cvtpk(v0[0], v0[1]); w.y = cvtpk(v0[2], v0[3]); w.z = cvtpk(v1[0], v1[1]); w.w = cvtpk(v1[2], v1[3]);
                    *(u32x4*)(rowp + bj * HALF) = w; } }
    }
};
__device__ __forceinline__ void rtab_update(LAS float* rtab, const float* ss, int pm) {
    __builtin_amdgcn_s_barrier();
    int tid = threadIdx.x; asm volatile("" : "+v"(tid));
    const int r = tid >> 1, hlf = tid & 1; const f32x4* sp = (const f32x4*)(ss + (size_t)(pm * BM + r) * 32) + 4 * hlf;
    const f32x4 a = sp[0], b = sp[1], c = sp[2], d = sp[3];
    float h = (((a[0] + a[1]) + (a[2] + a[3])) + ((b[0] + b[1]) + (b[2] + b[3]))) + (((c[0] + c[1]) + (c[2] + c[3])) + ((d[0] + d[1]) + (d[2] + d[3])));
    h += __shfl_xor(h, 1);
    if (hlf == 0) rtab[1 + r] = rsqrtf(h * (1.0f / DM) + EPS);
    if (tid == 0) ((LAS int*)rtab)[0] = pm;
    asm volatile("s_waitcnt lgkmcnt(0)" ::: "memory");
    __builtin_amdgcn_s_barrier();
}
template <int ACT> struct EpiBf16SS {
    static constexpr bool PERM = true;
    bf16_t* O; int ldc; const float* ss; LAS float* rtab;
    __device__ __forceinline__ void operator()(const f32x4 (&acc)[2][2][4][2], const Unit& u, int wr, int wc, int fr, int fq) const {
        const int row0 = u.pm * BM + wr * 64 + fr; const int col0 = u.pn * BM + wc * 32 + 8 * fq;
        if (((LAS const int*)rtab)[0] != u.pm) rtab_update(rtab, ss, u.pm);
#pragma unroll
        for (int ai = 0; ai < 2; ++ai)
#pragma unroll
            for (int m = 0; m < 4; ++m) { const int row = row0 + ai * HALF + m * 16; bf16_t* rowp = O + (size_t)row * ldc + col0;
                const float rs = rtab[1 + ai * HALF + wr * 64 + m * 16 + fr];
#pragma unroll
                for (int bj = 0; bj < 2; ++bj) { f32x4 v0 = acc[ai][bj][m][0] * rs, v1 = acc[ai][bj][m][1] * rs;
                    if (ACT == 1) {
#pragma unroll
                        for (int j = 0; j < 4; ++j) { float a = fmaxf(v0[j], 0.f), b = fmaxf(v1[j], 0.f); v0[j] = a * a; v1[j] = b * b; } }
                    u32x4 w; w.x = cvtpk(v0[0], v0[1]); w.y = cvtpk(v0[2], v0[3]); w.z = cvtpk(v1[0], v1[1]); w.w = cvtpk(v1[2], v1[3]);
                    *(u32x4*)(rowp + bj * HALF) = w; } }
    }
};
struct EpiResidualSS {
    static constexpr bool PERM = true;
    const float* src; float* dst; bf16_t* XB; float* ss;
    __device__ __forceinline__ void operator()(const f32x4 (&acc)[2][2][4][2], const Unit& u, int wr, int wc, int fr, int fq) const {
        const int row0 = u.pm * BM + wr * 64 + fr; const int col0 = u.pn * BM + wc * 32 + 8 * fq;
#pragma unroll
        for (int ai = 0; ai < 2; ++ai)
#pragma unroll
            for (int m = 0; m < 4; ++m) { const int row = row0 + ai * HALF + m * 16; const size_t off = (size_t)row * DM + col0; float s = 0.f;
#pragma unroll
                for (int bj = 0; bj < 2; ++bj) { const f32x4 a = *(const f32x4*)(src + off + bj * HALF) + acc[ai][bj][m][0], b = *(const f32x4*)(src + off + bj * HALF + 4) + acc[ai][bj][m][1];
                    *(f32x4*)(dst + off + bj * HALF) = a; *(f32x4*)(dst + off + bj * HALF + 4) = b;
                    u32x4 w; w.x = cvtpk(a[0], a[1]); w.y = cvtpk(a[2], a[3]); w.z = cvtpk(b[0], b[1]); w.w = cvtpk(b[2], b[3]);
                    *(u32x4*)(XB + off + bj * HALF) = w;
                    s += (a[0] * a[0] + a[1] * a[1]) + (a[2] * a[2] + a[3] * a[3]) + (b[0] * b[0] + b[1] * b[1]) + (b[2] * b[2] + b[3] * b[3]); }
                s += __shfl_xor(s, 16); s += __shfl_xor(s, 32);
                if (fq == 0) ss[(size_t)row * 32 + u.pn * 4 + wc] = s; }
    }
};
template <int LDC, int NCOLS> struct EpiRowScale {
    static constexpr bool PERM = true; static constexpr int ldc = LDC, lda = INW, ncols = NCOLS;
    bf16_t* O; const bf16_t* A; LAS float* rsum;
    __device__ __forceinline__ void operator()(const f32x4 (&acc)[2][2][4][2], const Unit& u, int wr, int wc, int fr, int fq) const {
        const int row0 = u.pm * BM + wr * 64 + fr; const int col0 = u.pn * BM + wc * 32 + 8 * fq;
        const float inv_n = 1.0f / (float)ncols;
#pragma unroll
        for (int ai = 0; ai < 2; ++ai) { const int lr = ai * HALF + wr * 64 + wc * 16 + fr;
            const bf16_t* rp = A + (size_t)(u.pm * BM + lr) * lda; float s = 0.f;
#pragma unroll 7
            for (int c = fq * 8; c < ncols; c += 32) { const u32x4 v = *(const u32x4*)(rp + c);
                float a;
                a = bflo(v.x); s += a * a; a = bfhi(v.x); s += a * a; a = bflo(v.y); s += a * a; a = bfhi(v.y); s += a * a;
                a = bflo(v.z); s += a * a; a = bfhi(v.z); s += a * a; a = bflo(v.w); s += a * a; a = bfhi(v.w); s += a * a; }
            s += __shfl_xor(s, 16); s += __shfl_xor(s, 32);
            if (fq == 0) rsum[lr] = rsqrtf(s * inv_n + EPS); }
        asm volatile("s_waitcnt lgkmcnt(0)" ::: "memory");
        __builtin_amdgcn_s_barrier();
#pragma unroll
        for (int ai = 0; ai < 2; ++ai)
#pragma unroll
            for (int m = 0; m < 4; ++m) { const int lr = ai * HALF + wr * 64 + m * 16 + fr; const float rs = rsum[lr];
                bf16_t* rowp = O + (size_t)(u.pm * BM + lr) * ldc + col0;
#pragma unroll
                for (int bj = 0; bj < 2; ++bj) { const f32x4 v0 = acc[ai][bj][m][0] * rs, v1 = acc[ai][bj][m][1] * rs;
                    u32x4 w; w.x = cvtpk(v0[0], v0[1]); w.y = cvtpk(v0[2], v0[3]); w.z = cvtpk(v1[0], v1[1]); w.w = cvtpk(v1[2], v1[3]);
                    *(u32x4*)(rowp + bj * HALF) = w; } }
        asm volatile("s_waitcnt lgkmcnt(0)" ::: "memory");
        __builtin_amdgcn_s_barrier();
        (void)row0;
    }
};
struct EpiResidual {
    static constexpr bool PERM = true;
    const float* src; float* dst; int ld;
    __device__ __forceinline__ void operator()(const f32x4 (&acc)[2][2][4][2], const Unit& u, int wr, int wc, int fr, int fq) const {
        const int row0 = u.pm * BM + wr * 64 + fr; const int col0 = u.pn * BM + wc * 32 + 8 * fq;
#pragma unroll
        for (int ai = 0; ai < 2; ++ai)
#pragma unroll
            for (int m = 0; m < 4; ++m) { const size_t off = (size_t)(row0 + ai * HALF + m * 16) * ld + col0;
#pragma unroll
                for (int bj = 0; bj < 2; ++bj) { const f32x4 a = *(const f32x4*)(src + off + bj * HALF), b = *(const f32x4*)(src + off + bj * HALF + 4);
                    *(f32x4*)(dst + off + bj * HALF) = a + acc[ai][bj][m][0]; *(f32x4*)(dst + off + bj * HALF + 4) = b + acc[ai][bj][m][1]; } }
    }
};

template <class Epi, class Sched>
__device__ __forceinline__ void gemm_phase(LAS unsigned char* lds, const Gemm g, const Sched& S, const Epi& E) {
    int tid_ = threadIdx.x; asm volatile("" : "+v"(tid_));
    const int tid = tid_, wid = __builtin_amdgcn_readfirstlane(tid >> 6), lane = tid & 63, wr = wid >> 2, wc = wid & 3, fr = lane & 15, fq = lane >> 4;
    const int K = g.K, nt = K / BK, lda = g.lda;
    unsigned voffA[2], voffB[2];
#pragma unroll
    for (int i = 0; i < 2; ++i) { int R, C; stage_rc(tid * 16 + i * 8192, R, C); const int Rb = Epi::PERM ? ((R & ~31) + perm32(R & 31)) : R;
        voffA[i] = (unsigned)(R * lda + C) * 2u; voffB[i] = (unsigned)(Rb * K + C) * 2u; }
    const size_t kstep = (size_t)(BK * 2);
    const size_t hstepA = (size_t)HALF * lda * 2, hstepB = (size_t)HALF * K * 2;
    const size_t tstepA = 2 * hstepA, tstepB = 2 * hstepB;
    const unsigned ldsw = (unsigned)wid * 1024u;
    const int aoff = lds_byte(wr * 64 + fr, fq * 8), boff = lds_byte(wc * 32 + fr, fq * 8);
#define PG8_SA(b, h) (((b) * 2 + (h)) * HTB)
#define PG8_SB(b, h) ((4 + (b) * 2 + (h)) * HTB)
#define PG8_STAGE(bufoff, gbase, voff) do { _Pragma("unroll") for (int _i = 0; _i < 2; ++_i) \
        __builtin_amdgcn_global_load_lds((const unsigned*)((const char*)(gbase) + (voff)[_i]), (LAS unsigned*)(lds + (bufoff) + ldsw + _i * 8192), 16, 0, 0); } while (0)
#define PG8_LDA(dst, b, h) do { _Pragma("unroll") for (int m = 0; m < 4; ++m) _Pragma("unroll") for (int k = 0; k < 2; ++k) dst[m][k] = *(const LAS bf16x8*)(lds + PG8_SA(b, h) + aoff + m * 2048 + k * 1024); } while (0)
#define PG8_LDB(dst, b, h) do { _Pragma("unroll") for (int n = 0; n < 2; ++n) _Pragma("unroll") for (int k = 0; k < 2; ++k) dst[n][k] = *(const LAS bf16x8*)(lds + PG8_SB(b, h) + boff + n * 2048 + k * 1024); } while (0)
#define PG8_MMA(ai, bj, At, Bt) do { __builtin_amdgcn_s_setprio(1); _Pragma("unroll") for (int m = 0; m < 4; ++m) _Pragma("unroll") for (int n = 0; n < 2; ++n) _Pragma("unroll") for (int k = 0; k < 2; ++k) \
        acc[ai][bj][m][n] = __builtin_amdgcn_mfma_f32_16x16x32_bf16(Bt[n][k], At[m][k], acc[ai][bj][m][n], 0, 0, 0); __builtin_amdgcn_s_setprio(0); } while (0)
#define PG8_WAIT_V(n) asm volatile("s_waitcnt vmcnt(" #n ")" ::: "memory")
#define PG8_WAIT_L(n) asm volatile("s_waitcnt lgkmcnt(" #n ")" ::: "memory")
#define PG8_BAR __builtin_amdgcn_s_barrier()
#define PG8_SCHED __builtin_amdgcn_sched_barrier(0)
    Unit cur, nxt; int ui = 0;
    if (!S.next(0, cur)) return;
    f32x4 acc[2][2][4][2];
#pragma unroll
    for (int a = 0; a < 2; ++a)
#pragma unroll
        for (int b = 0; b < 2; ++b)
#pragma unroll
            for (int m = 0; m < 4; ++m)
#pragma unroll
                for (int n = 0; n < 2; ++n) acc[a][b][m][n] = (f32x4){0.f, 0.f, 0.f, 0.f};
    bf16x8 At[4][2], B0[2][2], B1[2][2];
    const char* cA = (const char*)g.A + (size_t)cur.pm * tstepA; const char* cB = (const char*)g.Bt + (size_t)cur.pn * tstepB;
    PG8_STAGE(PG8_SB(0, 0), cB, voffB); PG8_STAGE(PG8_SB(0, 1), cB + hstepB, voffB); PG8_STAGE(PG8_SA(0, 0), cA, voffA); PG8_STAGE(PG8_SA(0, 1), cA + hstepA, voffA);
    if (wr == 1) PG8_BAR;
    PG8_WAIT_V(2); PG8_BAR;
    PG8_STAGE(PG8_SB(1, 0), cB + kstep, voffB); PG8_STAGE(PG8_SA(1, 0), cA + kstep, voffA); PG8_STAGE(PG8_SB(1, 1), cB + hstepB + kstep, voffB);
    PG8_WAIT_V(6); PG8_BAR;
    for (;;) {
        const bool has_next = S.next(ui + 1, nxt);
        const char* nA = has_next ? (const char*)g.A + (size_t)nxt.pm * tstepA : cA; const char* nB = has_next ? (const char*)g.Bt + (size_t)nxt.pn * tstepB : cB;
        for (int t = 0; t < nt; t += 2) {
            const bool last = (t == nt - 2);
            const char* a1 = cA + (size_t)(t + 1) * kstep;
            const char* a2 = last ? nA : cA + (size_t)(t + 2) * kstep; const char* b2 = last ? nB : cB + (size_t)(t + 2) * kstep;
            const char* a3 = a2 + kstep; const char* b3 = b2 + kstep;
            PG8_LDB(B0, 0, 0); PG8_LDB(B1, 0, 1); PG8_SCHED; PG8_LDA(At, 0, 0); PG8_STAGE(PG8_SA(1, 1), a1 + hstepA, voffA);
            PG8_WAIT_V(8); PG8_WAIT_L(0); PG8_BAR; PG8_MMA(0, 0, At, B0); PG8_MMA(0, 1, At, B1); PG8_BAR; PG8_SCHED;
            PG8_LDA(At, 0, 1); PG8_STAGE(PG8_SB(0, 0), b2, voffB); PG8_STAGE(PG8_SB(0, 1), b2 + hstepB, voffB); PG8_STAGE(PG8_SA(0, 0), a2, voffA);
            PG8_WAIT_V(8); PG8_WAIT_L(0); PG8_BAR; PG8_MMA(1, 0, At, B0); PG8_MMA(1, 1, At, B1); PG8_BAR; PG8_SCHED;
            PG8_LDB(B0, 1, 0); PG8_LDB(B1, 1, 1); PG8_SCHED; PG8_LDA(At, 1, 0); PG8_STAGE(PG8_SA(0, 1), a2 + hstepA, voffA);
            PG8_WAIT_V(8); PG8_WAIT_L(0); PG8_BAR; PG8_MMA(0, 0, At, B0); PG8_MMA(0, 1, At, B1); PG8_BAR; PG8_SCHED;
            PG8_LDA(At, 1, 1); PG8_STAGE(PG8_SB(1, 0), b3, voffB); PG8_STAGE(PG8_SB(1, 1), b3 + hstepB, voffB); PG8_STAGE(PG8_SA(1, 0), a3, voffA);
            PG8_WAIT_V(8); PG8_WAIT_L(0); PG8_BAR; PG8_MMA(1, 0, At, B0); PG8_MMA(1, 1, At, B1); PG8_BAR; PG8_SCHED;
        }
        if (wr == 0) PG8_BAR;
        E(acc, cur, wr, wc, fr, fq);
        if (!has_next) break;
#pragma unroll
        for (int a = 0; a < 2; ++a)
#pragma unroll
            for (int b = 0; b < 2; ++b)
#pragma unroll
                for (int m = 0; m < 4; ++m)
#pragma unroll
                    for (int n = 0; n < 2; ++n) acc[a][b][m][n] = (f32x4){0.f, 0.f, 0.f, 0.f};
        cur = nxt; cA = nA; cB = nB; ++ui;
        if (wr == 1) PG8_BAR;
    }
    PG8_WAIT_V(0);
    PG8_BAR;
#undef PG8_SA
#undef PG8_SB
#undef PG8_STAGE
#undef PG8_LDA
#undef PG8_LDB
#undef PG8_MMA
#undef PG8_WAIT_V
#undef PG8_WAIT_L
#undef PG8_BAR
#undef PG8_SCHED
}
}

__device__ __forceinline__ int crow(int r, int hi) { return (r & 3) + 8 * (r >> 2) + 4 * hi; }
__device__ __forceinline__ int v_st(int k, int c) { const int kk = (k & ~0xC) | ((k & 4) << 1) | ((k & 8) >> 1); return ((kk >> 3) * 4 + (c >> 5)) * 512 + ((kk & 7) * 32 + (c & 31)) * 2; }
__device__ __forceinline__ int v_rd_base(int lane) { return ((lane & 3) << 3) | (((lane >> 2) & 3) << 6) | (((lane >> 4) & 1) << 5) | (((lane >> 5) & 1) << 8); }
constexpr int v_rd_off(int d0, int ks, int half) { return d0 * 512 + ks * 4096 + half * 2048; }
template <int OFF> __device__ __forceinline__ s16x4 tr_read(int vb) {
    s16x4 r; asm volatile("ds_read_b64_tr_b16 %0, %1 offset:%2" : "=&v"(r) : "v"(vb), "i"(OFF) : "memory"); return r;
}
template <int D0> __device__ __forceinline__ void pv_one(f32x16& od, int vb, bf16x8 pa0, bf16x8 pa1, bf16x8 pa2, bf16x8 pa3) {
    const s16x4 l0 = tr_read<v_rd_off(D0, 0, 0)>(vb), h0 = tr_read<v_rd_off(D0, 0, 1)>(vb), l1 = tr_read<v_rd_off(D0, 1, 0)>(vb), h1 = tr_read<v_rd_off(D0, 1, 1)>(vb);
    const s16x4 l2 = tr_read<v_rd_off(D0, 2, 0)>(vb), h2 = tr_read<v_rd_off(D0, 2, 1)>(vb), l3 = tr_read<v_rd_off(D0, 3, 0)>(vb), h3 = tr_read<v_rd_off(D0, 3, 1)>(vb);
    asm volatile("s_waitcnt lgkmcnt(0)" ::: "memory"); __builtin_amdgcn_sched_barrier(0);
#define PK(L, H) (bf16x8){L[0], L[1], L[2], L[3], H[0], H[1], H[2], H[3]}
    od = __builtin_amdgcn_mfma_f32_32x32x16_bf16(pa0, PK(l0, h0), od, 0, 0, 0);
    od = __builtin_amdgcn_mfma_f32_32x32x16_bf16(pa1, PK(l1, h1), od, 0, 0, 0);
    od = __builtin_amdgcn_mfma_f32_32x32x16_bf16(pa2, PK(l2, h2), od, 0, 0, 0);
    od = __builtin_amdgcn_mfma_f32_32x32x16_bf16(pa3, PK(l3, h3), od, 0, 0, 0);
#undef PK
}

template <int DK, int MODE>
__device__ __forceinline__ void attn_unit(LAS unsigned char* lds,
        const bf16_t* __restrict__ Q, long ldq, const bf16_t* __restrict__ K, long ldk, const bf16_t* __restrict__ K2, long ldk2,
        const bf16_t* __restrict__ V, long ldv, bf16_t* __restrict__ O, long ldo, float* __restrict__ LSE, long ldlse,
        const f32x2* __restrict__ tabA, int qpos0, int qpstride, int kt_begin, int kt_end, int kbase, int q0sub, float C, float scale) {
    constexpr int ND = DK / 16, KROW = DK * 2, KB = 64 * KROW, NKC = (DK == 192) ? 3 : 2;
    int tid_ = threadIdx.x; asm volatile("" : "+v"(tid_));
    const int tid = tid_, wid = tid >> 6, lane = tid & 63, r32 = lane & 31, hi = lane >> 5;
    LAS unsigned char* Kl = lds; LAS unsigned char* Vl = lds + KB;
    LAS float* wsf = (LAS float*)(lds + KB + 16384) + wid * 64; LAS float* li_l = wsf; LAS float* al_l = wsf + 32;
    float m_reg = -1e30f, l_reg = 0.f; f32x16 o[4];
#pragma unroll
    for (int d = 0; d < 4; ++d)
#pragma unroll
        for (int r = 0; r < 16; ++r) o[d][r] = 0.f;
    bf16x8 qr[ND];
    { const bf16_t* Qw = Q + (size_t)(wid * 32 + r32) * ldq + hi * 8;
#pragma unroll
      for (int d0 = 0; d0 < ND; ++d0) qr[d0] = *(const bf16x8*)(Qw + d0 * 16); }
    if (MODE == 0) {
        const f32x2* tb = tabA + (size_t)(qpos0 + wid * 32 + r32) * 32 + hi * 8;
#pragma unroll
        for (int dd = 0; dd < 2; ++dd) {
            bf16x8 a = qr[8 + dd], b = qr[10 + dd], na, nb;
#pragma unroll
            for (int j = 0; j < 8; ++j) { const f32x2 cs = tb[dd * 16 + j]; const float x1 = bf2f((unsigned short)a[j]), x2 = bf2f((unsigned short)b[j]);
                na[j] = (short)f2bf(x1 * cs.x - x2 * cs.y); nb[j] = (short)f2bf(x1 * cs.y + x2 * cs.x); }
            qr[8 + dd] = na; qr[10 + dd] = nb;
        }
    }
    if (MODE == 2) {
        const f32x2* tb = tabA + (size_t)(qpos0 + (wid * 32 + r32) * qpstride) * 64 + hi * 8;
#pragma unroll
        for (int dd = 0; dd < 4; ++dd) { const bf16x8 xa = qr[dd], xb = qr[dd + 4]; bf16x8 na, nb;
#pragma unroll
            for (int j = 0; j < 8; ++j) { const f32x2 cs = tb[dd * 16 + j]; const float x1 = bf2f((unsigned short)xa[j]), x2 = bf2f((unsigned short)xb[j]);
                na[j] = (short)f2bf(x1 * cs.x - x2 * cs.y); nb[j] = (short)f2bf(x1 * cs.y + x2 * cs.x); }
            qr[dd] = na; qr[dd + 4] = nb; }
    }
    const int sr = tid >> 4, sc = (tid & 15) * 8;
    const int vst0 = v_st(sr, sc), vst1 = v_st(32 + sr, sc);
    int krow[NKC], kch[NKC], klds[NKC];
#pragma unroll
    for (int i = 0; i < NKC; ++i) {
        if (DK == 192) { const int id = tid + 512 * i; krow[i] = id / 24; kch[i] = id % 24; }
        else { krow[i] = sr + 32 * i; kch[i] = tid & 15; }
        klds[i] = krow[i] * KROW + ((kch[i] * 16) ^ ((krow[i] & 7) << 4));
    }
    const int vb = (int)(uintptr_t)Vl + v_rd_base(lane);
    bf16x8 kreg[NKC], vreg[2];
#define ALOAD(k0) do { _Pragma("unroll") for (int i = 0; i < NKC; ++i) { \
        if (DK == 192 && kch[i] >= 16) kreg[i] = *(const bf16x8*)(K2 + (size_t)((k0) + krow[i]) * ldk2 + (kch[i] - 16) * 8); \
        else kreg[i] = *(const bf16x8*)(K + (size_t)((k0) + krow[i]) * ldk + kch[i] * 8); } \
        vreg[0] = *(const bf16x8*)(V + (size_t)((k0) + sr) * ldv + sc); vreg[1] = *(const bf16x8*)(V + (size_t)((k0) + 32 + sr) * ldv + sc); } while (0)
    ALOAD(kbase + 64 * kt_begin);
    const int wq0 = q0sub + wid * 32;
    for (int kt = kt_begin; kt < kt_end; ++kt) {
        const int k0 = kbase + 64 * kt;
        __syncthreads();
#pragma unroll
        for (int i = 0; i < NKC; ++i) *(LAS bf16x8*)(Kl + klds[i]) = kreg[i];
        *(LAS bf16x8*)(Vl + vst0) = vreg[0]; *(LAS bf16x8*)(Vl + vst1) = vreg[1];
        __syncthreads();
        if (kt + 1 < kt_end) ALOAD(k0 + 64);
        bool part = true;
        if (MODE == 2) part = (k0 <= wq0 + 31 + 64) && (k0 + 63 >= wq0 - 64);
        if (part) {
            f32x16 p0, p1;
#pragma unroll
            for (int r = 0; r < 16; ++r) { p0[r] = 0.f; p1[r] = 0.f; }
#pragma unroll
            for (int d0 = 0; d0 < ND; ++d0) { const int cb = (d0 * 16 + hi * 8) * 2; const int off = r32 * KROW + (cb ^ ((r32 & 7) << 4));
                const bf16x8 b0 = *(const LAS bf16x8*)(Kl + off); const bf16x8 b1 = *(const LAS bf16x8*)(Kl + off + 32 * KROW);
                p0 = __builtin_amdgcn_mfma_f32_32x32x16_bf16(b0, qr[d0], p0, 0, 0, 0);
                p1 = __builtin_amdgcn_mfma_f32_32x32x16_bf16(b1, qr[d0], p1, 0, 0, 0); }
            if (MODE == 2) { const int kb = k0 - (wq0 + r32);
#pragma unroll
                for (int r = 0; r < 16; ++r) { const int d = kb + crow(r, hi); if (d > 64 || d < -64) p0[r] = -INFINITY; const int d1 = d + 32; if (d1 > 64 || d1 < -64) p1[r] = -INFINITY; } }
            float pmax = p0[0];
#pragma unroll
            for (int r = 1; r < 16; ++r) pmax = fmaxf(pmax, p0[r]);
#pragma unroll
            for (int r = 0; r < 16; ++r) pmax = fmaxf(pmax, p1[r]);
            { auto rr = __builtin_amdgcn_permlane32_swap(__float_as_uint(pmax), __float_as_uint(pmax), false, false);
              pmax = fmaxf(__uint_as_float(rr[0]), __uint_as_float(rr[1])); }
            const float mn = fmaxf(m_reg, pmax); const float alpha = __builtin_amdgcn_exp2f((m_reg - mn) * C); m_reg = mn;
            const float mnC = -mn * C;
#pragma unroll
            for (int r = 0; r < 16; ++r) { p0[r] = __builtin_amdgcn_exp2f(fmaf(p0[r], C, mnC)); p1[r] = __builtin_amdgcn_exp2f(fmaf(p1[r], C, mnC)); }
            float ps = 0.f;
#pragma unroll
            for (int r = 0; r < 16; ++r) ps += p0[r];
#pragma unroll
            for (int r = 0; r < 16; ++r) ps += p1[r];
            { auto rr = __builtin_amdgcn_permlane32_swap(__float_as_uint(ps), __float_as_uint(ps), false, false);
              ps = __uint_as_float(rr[0]) + __uint_as_float(rr[1]); }
            l_reg = l_reg * alpha + ps;
            bf16x8 pa0, pa1, pa2, pa3;
#define PK4(P, BASE, OUT) do { unsigned a0 = cvtpk(P[BASE + 0], P[BASE + 1]), a1 = cvtpk(P[BASE + 2], P[BASE + 3]);   \
            unsigned b0_ = cvtpk(P[BASE + 4], P[BASE + 5]), b1_ = cvtpk(P[BASE + 6], P[BASE + 7]);                              \
            auto r0 = __builtin_amdgcn_permlane32_swap(a0, b0_, false, false); auto r1 = __builtin_amdgcn_permlane32_swap(a1, b1_, false, false); \
            u32x4 w = {r0[0], r1[0], r0[1], r1[1]}; OUT = *reinterpret_cast<bf16x8*>(&w); } while (0)
            PK4(p0, 0, pa0); PK4(p0, 8, pa1); PK4(p1, 0, pa2); PK4(p1, 8, pa3);
#undef PK4
            if (__any(alpha < 1.f)) { if (hi == 0) al_l[r32] = alpha; LDS_WAIT();
#pragma unroll
                for (int r = 0; r < 16; ++r) { const float a = al_l[crow(r, hi)];
#pragma unroll
                    for (int d = 0; d < 4; ++d) o[d][r] *= a; }
                LDS_WAIT(); }
            pv_one<0>(o[0], vb, pa0, pa1, pa2, pa3); pv_one<1>(o[1], vb, pa0, pa1, pa2, pa3); pv_one<2>(o[2], vb, pa0, pa1, pa2, pa3); pv_one<3>(o[3], vb, pa0, pa1, pa2, pa3);
        }
    }
#undef ALOAD
    if (hi == 0) li_l[r32] = l_reg; LDS_WAIT();
    bf16_t* Ow = O + (size_t)(wid * 32) * ldo;
#pragma unroll
    for (int r = 0; r < 16; ++r) { const int orow = crow(r, hi); const float rl = 1.0f / li_l[orow];
#pragma unroll
        for (int d0 = 0; d0 < 4; ++d0) Ow[(size_t)orow * ldo + d0 * 32 + r32] = f2bf(o[d0][r] * rl); }
    if (MODE == 2) { if (hi == 0) LSE[(size_t)(wid * 32 + r32) * ldlse] = m_reg * scale + logf(l_reg); }
    LDS_WAIT();
}


template <int MODE> __device__ __forceinline__ void partialSM(f32x16& p0, f32x16& p1, float& m_reg, float& mn, float& alpha) {
    constexpr float SCALE = (MODE == 0) ? 0.07216878364870322f : 0.08838834764831845f, C = SCALE * LOG2E, THR = 8.f;
    float pmax = p0[0];
#pragma unroll
    for (int r = 1; r < 16; ++r) pmax = fmaxf(pmax, p0[r]);
#pragma unroll
    for (int r = 0; r < 16; ++r) pmax = fmaxf(pmax, p1[r]);
    { auto rr = __builtin_amdgcn_permlane32_swap(__float_as_uint(pmax), __float_as_uint(pmax), false, false);
      pmax = fmaxf(__uint_as_float(rr[0]), __uint_as_float(rr[1])); }
    if (__builtin_expect(__all(pmax - m_reg <= THR / SCALE), 1)) { mn = m_reg; alpha = 1.f; }
    else { mn = fmaxf(m_reg, pmax); alpha = __builtin_amdgcn_exp2f((m_reg - mn) * C); m_reg = mn; }
    const float mnC = -mn * C;
#pragma unroll
    for (int r = 0; r < 16; ++r) p0[r] = fmaf(p0[r], C, mnC);
#pragma unroll
    for (int r = 0; r < 16; ++r) p1[r] = fmaf(p1[r], C, mnC);
#pragma unroll
    for (int r = 0; r < 16; ++r) p0[r] = __builtin_amdgcn_exp2f(p0[r]);
}
__device__ __forceinline__ void finishSM(f32x16& p0, f32x16& p1, float alpha, float& l_reg, bf16x8& pa0, bf16x8& pa1, bf16x8& pa2, bf16x8& pa3) {
#pragma unroll
    for (int r = 0; r < 16; ++r) p1[r] = __builtin_amdgcn_exp2f(p1[r]);
    float ps = 0.f;
#pragma unroll
    for (int r = 0; r < 16; ++r) ps += p0[r];
#pragma unroll
    for (int r = 0; r < 16; ++r) ps += p1[r];
    { auto rr = __builtin_amdgcn_permlane32_swap(__float_as_uint(ps), __float_as_uint(ps), false, false);
      ps = __uint_as_float(rr[0]) + __uint_as_float(rr[1]); }
    l_reg = l_reg * alpha + ps;
#define PK4(P, BASE, OUT) do { unsigned a0 = cvtpk(P[BASE + 0], P[BASE + 1]), a1 = cvtpk(P[BASE + 2], P[BASE + 3]);   \
    unsigned b0_ = cvtpk(P[BASE + 4], P[BASE + 5]), b1_ = cvtpk(P[BASE + 6], P[BASE + 7]);                              \
    auto r0 = __builtin_amdgcn_permlane32_swap(a0, b0_, false, false); auto r1 = __builtin_amdgcn_permlane32_swap(a1, b1_, false, false); \
    u32x4 w = {r0[0], r1[0], r0[1], r1[1]}; OUT = *reinterpret_cast<bf16x8*>(&w); } while (0)
    PK4(p0, 0, pa0); PK4(p0, 8, pa1); PK4(p1, 0, pa2); PK4(p1, 8, pa3);
#undef PK4
}
template <int DK> __device__ __forceinline__ void qkt(f32x16& p0, f32x16& p1, LAS const unsigned char* Ks, const bf16x8* qr, LAS const unsigned char* qpe, int r32, int hi) {
    constexpr int ND = DK / 16, KROW = DK * 2;
#pragma unroll
    for (int r = 0; r < 16; ++r) { p0[r] = 0.f; p1[r] = 0.f; }
#pragma unroll
    for (int d0 = 0; d0 < ND; ++d0) { const int cb = (d0 * 16 + hi * 8) * 2; const int off = r32 * KROW + (cb ^ ((r32 & 7) << 4));
        const bf16x8 b0 = *(const LAS bf16x8*)(Ks + off); const bf16x8 b1 = *(const LAS bf16x8*)(Ks + off + 32 * KROW);
        bf16x8 q; if (d0 < 8) q = qr[d0]; else q = *(const LAS bf16x8*)(qpe + (d0 - 8) * 1024);
        p0 = __builtin_amdgcn_mfma_f32_32x32x16_bf16(b0, q, p0, 0, 0, 0);
        p1 = __builtin_amdgcn_mfma_f32_32x32x16_bf16(b1, q, p1, 0, 0, 0); }
}
__device__ __forceinline__ void pv_d0(f32x16* o, int vb, bf16x8 pa0, bf16x8 pa1, bf16x8 pa2, bf16x8 pa3) {
    pv_one<0>(o[0], vb, pa0, pa1, pa2, pa3); pv_one<1>(o[1], vb, pa0, pa1, pa2, pa3); pv_one<2>(o[2], vb, pa0, pa1, pa2, pa3); pv_one<3>(o[3], vb, pa0, pa1, pa2, pa3);
}
#define SBAR() __builtin_amdgcn_sched_barrier(0)
template <int DK, int MODE>
__device__ __forceinline__ void attn_pipe(LAS unsigned char* lds,
        const bf16_t* __restrict__ Q, const bf16_t* __restrict__ K, const bf16_t* __restrict__ K2,
        bf16_t* __restrict__ O, const f32x2* __restrict__ tabA, int qpos0, const float* __restrict__ gq) {
    constexpr int ldq = (MODE == 0) ? 768 : INW, ldk = (MODE == 0) ? 1024 : INW, ldk2 = INW, ldo = 1280, VOFF = (MODE == 0) ? 128 : 256;
    constexpr int ND = DK / 16, KROW = DK * 2, SHM_K = 64 * KROW, SHM_V = 16384, NKC = (DK == 192) ? 3 : 2, NT = SEQ / 64;
    int tid_ = threadIdx.x; asm volatile("" : "+v"(tid_));
    const int tid = tid_, wid = tid >> 6, lane = tid & 63, r32 = lane & 31, hi = lane >> 5;
    LAS unsigned char* V_lds = lds; LAS unsigned char* K_lds = lds + 2 * SHM_V;
    LAS float* wsf = (LAS float*)(lds + 2 * SHM_V + 2 * SHM_K) + wid * 64; LAS float* li_l = wsf; LAS float* al_l = wsf + 32;
    float m_reg = -1e30f, l_reg = 0.f; f32x16 o[4];
#pragma unroll
    for (int d = 0; d < 4; ++d)
#pragma unroll
        for (int r = 0; r < 16; ++r) o[d][r] = 0.f;
    bf16x8 qr[8];
    LAS unsigned char* qpe = lds + 2 * SHM_V + 2 * SHM_K + 2048 + wid * 4096 + lane * 16;
    const bf16_t* Qw = Q + (size_t)(wid * 32 + r32) * ldq + hi * 8;
#pragma unroll
    for (int d0 = 0; d0 < 8; ++d0) qr[d0] = *(const bf16x8*)(Qw + d0 * 16);
    if (MODE == 0) {
        const f32x2* tb = tabA + (size_t)(qpos0 + wid * 32 + r32) * 32 + hi * 8;
#pragma unroll
        for (int dd = 0; dd < 2; ++dd) {
            const bf16x8 a = *(const bf16x8*)(Qw + (8 + dd) * 16), b = *(const bf16x8*)(Qw + (10 + dd) * 16); bf16x8 na, nb;
#pragma unroll
            for (int j = 0; j < 8; ++j) { const f32x2 cs = tb[dd * 16 + j]; const float x1 = bf2f((unsigned short)a[j]), x2 = bf2f((unsigned short)b[j]);
                na[j] = (short)f2bf(x1 * cs.x - x2 * cs.y); nb[j] = (short)f2bf(x1 * cs.y + x2 * cs.x); }
            *(LAS bf16x8*)(qpe + dd * 1024) = na; *(LAS bf16x8*)(qpe + (2 + dd) * 1024) = nb;
        }
    }
    if (MODE == 1) {
        float ssq = 0.f;
#pragma unroll
        for (int d0 = 0; d0 < 8; ++d0)
#pragma unroll
            for (int j = 0; j < 8; ++j) { const float x = bf2f((unsigned short)qr[d0][j]); ssq += x * x; }
        ssq += __shfl_xor(ssq, 32);
        const float rq = rsqrtf(ssq * (1.0f / 128.0f) + EPS);
        const int pos = qpos0 + wid * 32 + r32;
#pragma unroll
        for (int hf = 0; hf < 2; ++hf) {
            const f32x2* tb = tabA + (size_t)(hf == 0 ? (pos >> 6) : (pos & 63)) * 32 + hi * 8;
#pragma unroll
            for (int dd = 0; dd < 2; ++dd) { const int da = hf * 4 + dd, db = da + 2;
                const bf16x8 xa = qr[da], xb = qr[db]; bf16x8 na, nb;
                const float* g1 = gq + da * 16 + hi * 8; const float* g2 = gq + db * 16 + hi * 8;
#pragma unroll
                for (int j = 0; j < 8; ++j) { const f32x2 cs = tb[dd * 16 + j];
                    const float y1 = bf2f((unsigned short)xa[j]) * rq * g1[j], y2 = bf2f((unsigned short)xb[j]) * rq * g2[j];
                    na[j] = (short)f2bf(y1 * cs.x - y2 * cs.y); nb[j] = (short)f2bf(y1 * cs.y + y2 * cs.x); }
                qr[da] = na; qr[db] = nb; }
        }
    }
    const int sr = tid >> 4, sc = (tid & 15) * 8;
    const int vst0 = v_st(sr, sc), vst1 = v_st(32 + sr, sc);
    const int klds0 = sr * KROW + ((sc * 2) ^ ((sr & 7) << 4));
    const int klds2 = (tid >> 3) * KROW + ((256 + (tid & 7) * 16) ^ (((tid >> 3) & 7) << 4));
    const int vb0 = (int)(uintptr_t)V_lds + v_rd_base(lane);
    const bf16_t* kp = K + (size_t)sr * ldk + sc;
    const bf16_t* kp2 = (DK == 192) ? (K2 + (size_t)(tid >> 3) * ldk2 + (tid & 7) * 8) : nullptr;
    bf16x8 kreg[NKC], vreg[2];
#define SLOAD(k0) do { const bf16_t* a0_ = kp + (size_t)(k0) * ldk; kreg[0] = *(const bf16x8*)a0_; vreg[0] = *(const bf16x8*)(a0_ + VOFF); \
        kreg[1] = *(const bf16x8*)(a0_ + 32 * ldk); vreg[1] = *(const bf16x8*)(a0_ + 32 * ldk + VOFF); \
        if (DK == 192) kreg[NKC - 1] = *(const bf16x8*)(kp2 + (size_t)(k0) * ldk2); } while (0)
#define SWRITE(b) do { *(LAS bf16x8*)(K_lds + (b) * SHM_K + klds0) = kreg[0]; *(LAS bf16x8*)(K_lds + (b) * SHM_K + klds0 + 32 * KROW) = kreg[1]; \
        if (DK == 192) *(LAS bf16x8*)(K_lds + (b) * SHM_K + klds2) = kreg[NKC - 1]; \
        *(LAS bf16x8*)(V_lds + (b) * SHM_V + vst0) = vreg[0]; *(LAS bf16x8*)(V_lds + (b) * SHM_V + vst1) = vreg[1]; } while (0)
#define SWAIT() asm volatile("s_waitcnt vmcnt(0)" ::: "memory")
#define RESC(a) do { if (__any((a) < 1.f)) { if (hi == 0) al_l[r32] = (a); LDS_WAIT(); \
        _Pragma("unroll") for (int r = 0; r < 16; ++r) { const float a_ = al_l[crow(r, hi)]; _Pragma("unroll") for (int d = 0; d < 4; ++d) o[d][r] *= a_; } } } while (0)
    f32x16 pA0, pA1, pB0, pB1; float mnA, mnB, alA, alB; bf16x8 pa0, pa1, pa2, pa3;
    __syncthreads();
    SLOAD(0); SWAIT(); SWRITE(0); __syncthreads();
    qkt<DK>(pA0, pA1, K_lds, qr, qpe, r32, hi); partialSM<MODE>(pA0, pA1, m_reg, mnA, alA);
    SLOAD(64); SWAIT(); SWRITE(1); __syncthreads();
    for (int j = 1; j + 1 < NT; j += 2) {
        SBAR(); qkt<DK>(pB0, pB1, K_lds + SHM_K, qr, qpe, r32, hi);
        finishSM(pA0, pA1, alA, l_reg, pa0, pa1, pa2, pa3); SBAR();
        SLOAD((j + 1) * 64); SBAR();
        pv_d0(o, vb0, pa0, pa1, pa2, pa3); partialSM<MODE>(pB0, pB1, m_reg, mnB, alB);
        __syncthreads(); SWAIT(); SWRITE(0);
        RESC(alB); __syncthreads();
        SBAR(); qkt<DK>(pA0, pA1, K_lds, qr, qpe, r32, hi);
        finishSM(pB0, pB1, alB, l_reg, pa0, pa1, pa2, pa3); SBAR();
        SLOAD((j + 2) * 64); SBAR();
        pv_d0(o, vb0 + SHM_V, pa0, pa1, pa2, pa3); partialSM<MODE>(pA0, pA1, m_reg, mnA, alA);
        __syncthreads(); SWAIT(); SWRITE(1);
        RESC(alA); __syncthreads();
    }
    SBAR(); qkt<DK>(pB0, pB1, K_lds + SHM_K, qr, qpe, r32, hi);
    finishSM(pA0, pA1, alA, l_reg, pa0, pa1, pa2, pa3); SBAR();
    pv_d0(o, vb0, pa0, pa1, pa2, pa3); partialSM<MODE>(pB0, pB1, m_reg, mnB, alB);
    __syncthreads(); RESC(alB);
    finishSM(pB0, pB1, alB, l_reg, pa0, pa1, pa2, pa3); SBAR();
    pv_d0(o, vb0 + SHM_V, pa0, pa1, pa2, pa3);
    if (hi == 0) li_l[r32] = l_reg; LDS_WAIT();
    bf16_t* Ow = O + (size_t)(wid * 32) * ldo;
#pragma unroll
    for (int r = 0; r < 16; ++r) { const int orow = crow(r, hi); const float rl = __builtin_amdgcn_rcpf(li_l[orow]);
#pragma unroll
        for (int d0 = 0; d0 < 4; ++d0) Ow[(size_t)orow * ldo + d0 * 32 + r32] = f2bf(o[d0][r] * rl); }
    LDS_WAIT();
#undef SLOAD
#undef SWRITE
#undef SWAIT
#undef RESC
}

__device__ __forceinline__ void transpose_item(const float* __restrict__ W, int Ksrc, int N, const float* __restrict__ gk, bf16_t* __restrict__ WT, int Kdst, LAS float* scr, int item, int lane) {
    const int nblk = N / 32, kb = item / nblk, nb = item % nblk, k0 = 64 * kb, n0 = 32 * nb;
    float tv[32];
#pragma unroll
    for (int i = 0; i < 32; ++i) { const int k = k0 + 2 * i + (lane >> 5); tv[i] = (k < Ksrc) ? W[(size_t)k * N + n0 + (lane & 31)] : 0.f; }
#pragma unroll
    for (int i = 0; i < 32; ++i) scr[(2 * i + (lane >> 5)) * 33 + (lane & 31)] = tv[i];
    LDS_WAIT();
    const int c = lane & 7;
    f32x4 ga = (f32x4){1.f, 1.f, 1.f, 1.f}, gb = ga;
    if (gk && k0 + 8 * c < Ksrc) { ga = *(const f32x4*)(gk + k0 + 8 * c); gb = *(const f32x4*)(gk + k0 + 8 * c + 4); }
#pragma unroll
    for (int j = 0; j < 4; ++j) { const int n = (lane >> 3) + 8 * j; const LAS float* s = scr + (8 * c) * 33 + n;
        u32x4 o; o.x = cvtpk(s[0 * 33] * ga[0], s[1 * 33] * ga[1]); o.y = cvtpk(s[2 * 33] * ga[2], s[3 * 33] * ga[3]); o.z = cvtpk(s[4 * 33] * gb[0], s[5 * 33] * gb[1]); o.w = cvtpk(s[6 * 33] * gb[2], s[7 * 33] * gb[3]);
        *(u32x4*)(WT + (size_t)(n0 + n) * Kdst + k0 + 8 * c) = o; }
    LDS_WAIT();
}
__device__ __forceinline__ void rms_row_bf16(const float* __restrict__ xrow, const float* __restrict__ g, bf16_t* __restrict__ orow, int lane) {
    const f32x4* xr = (const f32x4*)xrow + lane; const f32x4* gr = (const f32x4*)g + lane;
    f32x4 v[8]; float s = 0.f;
#pragma unroll
    for (int j = 0; j < 8; ++j) { v[j] = xr[64 * j]; s += (v[j].x * v[j].x + v[j].y * v[j].y) + (v[j].z * v[j].z + v[j].w * v[j].w); }
    const float r = rsqrtf(wave_sum(s) * (1.0f / DM) + EPS);
    u32x2* o8 = (u32x2*)orow + lane;
#pragma unroll
    for (int j = 0; j < 8; ++j) { const f32x4 gg = gr[64 * j]; u32x2 w; w.x = cvtpk(v[j].x * r * gg.x, v[j].y * r * gg.y); w.y = cvtpk(v[j].z * r * gg.z, v[j].w * r * gg.w); o8[64 * j] = w; }
}
__device__ __forceinline__ void xb_row(const float* __restrict__ xrow, bf16_t* __restrict__ orow, float* __restrict__ ssp, int lane) {
    const f32x4* xr = (const f32x4*)xrow + lane; f32x4 v[8]; float s = 0.f;
#pragma unroll
    for (int j = 0; j < 8; ++j) { v[j] = xr[64 * j]; s += (v[j].x * v[j].x + v[j].y * v[j].y) + (v[j].z * v[j].z + v[j].w * v[j].w); }
    s = wave_sum(s);
    u32x2* o8 = (u32x2*)orow + lane;
#pragma unroll
    for (int j = 0; j < 8; ++j) { u32x2 w; w.x = cvtpk(v[j].x, v[j].y); w.y = cvtpk(v[j].z, v[j].w); o8[64 * j] = w; }
    if (lane < 32) ssp[lane] = (lane == 0) ? s : 0.f;
}
__device__ __forceinline__ void rms_row_f32(const float* __restrict__ xrow, const float* __restrict__ g, float* __restrict__ orow, int lane) {
    const f32x4* xr = (const f32x4*)xrow + lane; const f32x4* gr = (const f32x4*)g + lane;
    f32x4 v[8]; float s = 0.f;
#pragma unroll
    for (int j = 0; j < 8; ++j) { v[j] = xr[64 * j]; s += (v[j].x * v[j].x + v[j].y * v[j].y) + (v[j].z * v[j].z + v[j].w * v[j].w); }
    const float r = rsqrtf(wave_sum(s) * (1.0f / DM) + EPS);
    f32x4* o = (f32x4*)orow + lane;
#pragma unroll
    for (int j = 0; j < 8; ++j) { const f32x4 gg = gr[64 * j]; o[64 * j] = v[j] * r * gg; }
}
__device__ __forceinline__ void sincos_rev(float ang, float& c, float& s) {
    const double rev = (double)ang * 0.15915494309189535; const double fr = rev - rint(rev); const float f = (float)fr;
    s = __builtin_amdgcn_sinf(f); c = __builtin_amdgcn_cosf(f);
}

#ifndef PH_MASK
#define PH_MASK 0xFFFF
#endif
#define PH(k) ((PH_MASK >> (k)) & 1)
#ifndef REP_ATTN
#define REP_ATTN 1
#endif
#ifndef REP_FF1
#define REP_FF1 1
#endif
#ifndef REP_P1
#define REP_P1 1
#endif
#ifndef REP_P2
#define REP_P2 1
#endif
#ifndef REP_C
#define REP_C 1
#endif
#ifndef REP_ROW
#define REP_ROW 1
#endif
#ifndef REP_SYNC
#define REP_SYNC 0
#endif
#ifndef REP_P3G
#define REP_P3G 1
#endif
#ifndef REP_P5
#define REP_P5 1
#endif
#ifndef REP_P6X
#define REP_P6X 0
#endif
#ifndef REP_FF2X
#define REP_FF2X 0
#endif


constexpr int I_IN = (DM / 64) * (INW / 32), I_UQ = (512 / 64) * (768 / 32), I_UKV = (512 / 64) * (1024 / 32), I_OUT = (DM / 64) * (DM / 32),
              I_1 = (DM / 64) * (DFF / 32), I_2 = (DFF / 64) * (DM / 32), NIT = I_IN + I_UQ + I_UKV + I_OUT + I_1 + I_2;
static_assert(NIT % 8 == 0, "block items of 8 wave items");
#define XB_TMO      128
#define XB_XCNT(j)  (256  + 64 * (j))
#define XB_XSUB(j)  (1280 + 64 * (j))
#define XB_XGEN(j)  (2304 + 64 * (j))
#define XB_TOP      3328
#define XB_TOPGEN   3392
#define XCD_BAR_WORDS 3456
#define XB_SPIN_CAP (1u << 18)
constexpr int CW_BAR = 512;
static_assert((CW_BAR + XCD_BAR_WORDS) * 4 <= 16384, "control region");
__device__ __forceinline__ unsigned xb_ld(unsigned* p)              { return __hip_atomic_load(p, __ATOMIC_RELAXED, __HIP_MEMORY_SCOPE_AGENT); }
__device__ __forceinline__ unsigned xb_add(unsigned* p, unsigned v) { return __hip_atomic_fetch_add(p, v, __ATOMIC_RELAXED, __HIP_MEMORY_SCOPE_AGENT); }
__device__ __forceinline__ unsigned xb_xcc_id() { return (unsigned)__builtin_amdgcn_s_getreg((3 << 11) | 20) & 0xFu; }
#define XB_SPIN(cond, bar) do { unsigned _sp = 0; while (cond) { __builtin_amdgcn_s_sleep(1); \
    if ((++_sp & 255u) == 0u) { if (xb_ld(&(bar)[XB_TMO])) break; if (_sp > XB_SPIN_CAP) { atomicAdd(&(bar)[XB_TMO], 1u); break; } } } } while (0)
__device__ __forceinline__ void xcd_barrier_complete(unsigned* bar, unsigned x, unsigned& nloc, unsigned& nx) {
    const unsigned G = gridDim.x;
    unsigned sum, cnt, mine, sp = 0u;
    for (;;) {
        sum = 0u; cnt = 0u; mine = 0u;
#pragma unroll
        for (unsigned j = 0; j < 16; ++j) { const unsigned c = xb_ld(&bar[XB_XCNT(j)]); sum += c; cnt += (c > 0u) ? 1u : 0u; mine = (j == x) ? c : mine; }
        if (sum == G) break;
        __builtin_amdgcn_s_sleep(1);
        if ((++sp & 255u) == 0u) { if (xb_ld(&bar[XB_TMO])) break; if (sp > XB_SPIN_CAP) { atomicAdd(&bar[XB_TMO], 1u); break; } }
    }
    nloc = mine > 0u ? mine : 1u; nx = cnt > 0u ? cnt : 1u;
}
__device__ __forceinline__ void xcd_barrier(unsigned* bar, volatile LAS unsigned* st) {
    asm volatile("s_waitcnt vmcnt(0)" ::: "memory");
    __syncthreads();
    if (threadIdx.x == 0) {
        __builtin_amdgcn_s_waitcnt(0);
        const unsigned x = xb_xcc_id();
        unsigned nloc = st[0], nx = st[1];
        if (nloc == 0u) { xcd_barrier_complete(bar, x, nloc, nx); st[0] = nloc; st[1] = nx; }
        const unsigned old = xb_add(&bar[XB_XSUB(x)], 1u);
        const unsigned gen = old / nloc;
        if (old + 1u == (gen + 1u) * nloc) {
            __builtin_amdgcn_fence(__ATOMIC_RELEASE, "agent");
            asm volatile("s_waitcnt vmcnt(0)" ::: "memory");
            const unsigned og = xb_add(&bar[XB_TOP], 1u);
            const unsigned tg = og / nx;
            if (og + 1u == (tg + 1u) * nx) xb_add(&bar[XB_TOPGEN], 1u);
            else XB_SPIN(xb_ld(&bar[XB_TOPGEN]) == tg, bar);
            __builtin_amdgcn_fence(__ATOMIC_ACQUIRE, "agent");
            xb_add(&bar[XB_XGEN(x)], 1u);
            asm volatile("s_waitcnt vmcnt(0)" ::: "memory");
        } else {
            XB_SPIN(xb_ld(&bar[XB_XGEN(x)]) == gen, bar);
            __builtin_amdgcn_fence(__ATOMIC_ACQUIRE, "agent");
            asm volatile("s_waitcnt vmcnt(0)" ::: "memory");
        }
    }
    __syncthreads();
}

struct Params { const float* in[15]; float* out; unsigned char* ws; };
#define KAS __attribute__((address_space(4)))
__device__ __forceinline__ void conv_item(int r, int layer, const KAS Params* pp, unsigned char* wb, LAS float* scr, int lane) {
    const size_t L = (size_t)layer;
    if (r < I_IN) { transpose_item(pp->in[2] + L * DM * INW, DM, INW, pp->in[1] + L * DM, (bf16_t*)(wb + (WS_WIN - WS_WIN)), DM, scr, r, lane); return; } r -= I_IN;
    if (r < I_UQ) { transpose_item(pp->in[4] + L * 448 * 768, 448, 768, pp->in[3] + L * 448, (bf16_t*)(wb + (WS_WUQ - WS_WIN)), 512, scr, r, lane); return; } r -= I_UQ;
    if (r < I_UKV) { transpose_item(pp->in[6] + L * 512 * 1024, 512, 1024, pp->in[5] + L * 512, (bf16_t*)(wb + (WS_WUKV - WS_WIN)), 512, scr, r, lane); return; } r -= I_UKV;
    if (r < I_OUT) { transpose_item(pp->in[10] + L * DM * DM, DM, DM, nullptr, (bf16_t*)(wb + (WS_WOUT - WS_WIN)), DM, scr, r, lane); return; } r -= I_OUT;
    if (r < I_1) { transpose_item(pp->in[12] + L * DM * DFF, DM, DFF, pp->in[11] + L * DM, (bf16_t*)(wb + (WS_W1 - WS_WIN)), DM, scr, r, lane); return; } r -= I_1;
    transpose_item(pp->in[13] + L * DFF * DM, DFF, DM, nullptr, (bf16_t*)(wb + (WS_W2 - WS_WIN)), DFF, scr, r, lane);
}


__global__ void __launch_bounds__(512, 2) mega_fwd(Params p) {
    extern __shared__ __attribute__((aligned(16))) unsigned char smem[];
    LAS unsigned char* lds = (LAS unsigned char*)smem;
    cg::grid_group grid = cg::this_grid();
    const int tid0 = threadIdx.x, wid = __builtin_amdgcn_readfirstlane(tid0 >> 6);
#define FRESH() int tid = tid0; asm volatile("" : "+v"(tid)); const int lane = tid & 63; (void)lane
    const int G = gridDim.x, gw = blockIdx.x * 8 + wid, NGW = G * 8;
#define WSPTRS() WSPTRS_L(0)
#define WSPTRS_L(LL) const KAS Params* ppw = (const KAS Params*)__builtin_amdgcn_kernarg_segment_ptr(); asm volatile("" : "+s"(ppw)); unsigned char* ws = ppw->ws; \
    unsigned* ctl = (unsigned*)(ws + WS_CTL); f32x2* tabC = (f32x2*)(ws + WS_TABC); f32x2* tabA = (f32x2*)(ws + WS_TABA); \
    unsigned char* wb_ = ws + (((LL) & 1) ? WS_WB1 : WS_WIN); \
    bf16_t* Win = (bf16_t*)(wb_); bf16_t* Wuq = (bf16_t*)(wb_ + (WS_WUQ - WS_WIN)); bf16_t* Wukv = (bf16_t*)(wb_ + (WS_WUKV - WS_WIN)); \
    bf16_t* Wout = (bf16_t*)(wb_ + (WS_WOUT - WS_WIN)); bf16_t* W1 = (bf16_t*)(wb_ + (WS_W1 - WS_WIN)); bf16_t* W2 = (bf16_t*)(wb_ + (WS_W2 - WS_WIN)); \
    float* X = (float*)(ws + WS_X); bf16_t* H = (bf16_t*)(ws + WS_H); bf16_t* PROJ = (bf16_t*)(ws + WS_PROJ); \
    bf16_t* QA = (bf16_t*)(ws + WS_QA); bf16_t* KVA = (bf16_t*)(ws + WS_KVA); bf16_t* OAB = (bf16_t*)(ws + WS_OAB); \
    bf16_t* OC = (bf16_t*)(ws + WS_OC); float* LSEB = (float*)(ws + WS_LSE); bf16_t* U = (bf16_t*)(ws + WS_U); \
    bf16_t* XB1 = (bf16_t*)(ws + WS_XB1); bf16_t* XB2 = (bf16_t*)(ws + WS_XB2); float* SS1 = (float*)(ws + WS_SS1); float* SS2 = (float*)(ws + WS_SS2); \
    (void)ctl; (void)tabC; (void)tabA; (void)Win; (void)Wuq; (void)Wukv; (void)Wout; (void)W1; (void)W2; (void)X; (void)H; (void)PROJ; (void)QA; (void)KVA; (void)OAB; (void)OC; (void)LSEB; (void)U; (void)XB1; (void)XB2; (void)SS1; (void)SS2
#define LPTRS() int ll = l; asm volatile("" : "+s"(ll)); const KAS Params* ppl = (const KAS Params*)__builtin_amdgcn_kernarg_segment_ptr(); asm volatile("" : "+s"(ppl)); \
    const float* x_in = ppl->in[0]; const float* ln1_g = ppl->in[1] + (size_t)ll * DM; const float* w_in = ppl->in[2] + (size_t)ll * DM * INW; \
    const float* g_q_a = ppl->in[3] + (size_t)ll * 448; const float* w_uq = ppl->in[4] + (size_t)ll * 448 * 768; const float* g_kv_a = ppl->in[5] + (size_t)ll * 512; \
    const float* w_ukv = ppl->in[6] + (size_t)ll * 512 * 1024; const float* g_qn_b = ppl->in[7] + (size_t)ll * 128; const float* g_kn_b = ppl->in[8] + (size_t)ll * 128; \
    const float* g_out = ppl->in[9] + (size_t)ll * DM; const float* w_out = ppl->in[10] + (size_t)ll * DM * DM; const float* ln2_g = ppl->in[11] + (size_t)ll * DM; \
    const float* w_ff1 = ppl->in[12] + (size_t)ll * DM * DFF; const float* w_ff2 = ppl->in[13] + (size_t)ll * DFF * DM; \
    (void)x_in; (void)ln1_g; (void)w_in; (void)g_q_a; (void)w_uq; (void)g_kv_a; (void)w_ukv; (void)g_qn_b; (void)g_kn_b; (void)g_out; (void)w_out; (void)ln2_g; (void)w_ff1; (void)w_ff2
    volatile LAS unsigned* xst = (volatile LAS unsigned*)(lds + 131072 + 16);
    if (tid0 == 0) { xst[0] = 0u; xst[1] = 0u; }
    __syncthreads();
    { WSPTRS(); if (blockIdx.x == 0) for (int i = tid0; i < 4096; i += 512) ctl[i] = 0u; }
#define GSYNC() do { WSPTRS(); xcd_barrier(ctl + CW_BAR, xst); } while (0)
    {
        FRESH(); WSPTRS();
        const int NT_ = G * 512;
        const float l2t = 13.287712379549449f;
        for (int base = blockIdx.x * 512; base < 4096 * 64; base += NT_) { const int i = base + tid; const int pos = i >> 6, k = i & 63; const float inv = exp2f(-((float)(2 * k) / 128.0f) * l2t);
            const float ang = (float)pos * inv; float c, s; sincos_rev(ang, c, s); tabC[i] = (f32x2){c, s}; }
        for (int base = blockIdx.x * 512; base < 4096 * 32; base += NT_) { const int i = base + tid; const int pos = i >> 5, k = i & 31; const float inv = exp2f(-((float)(2 * k) / 64.0f) * l2t);
            const float ang = (float)pos * inv; float c, s; sincos_rev(ang, c, s); tabA[i] = (f32x2){c, s}; }
    }

    for (int l = 0; l < DEPTH; ++l) {
        if (l == 0) {
            for (int rep = 0; rep < REP_P1; ++rep) {
                FRESH(); WSPTRS();
                LAS float* scr = (LAS float*)(lds + wid * 16384);
                for (int it = gw; it < NIT; it += NGW) conv_item(it, 0, ppw, ws + WS_WIN, scr, lane);
                for (int m = gw; m < T; m += NGW) xb_row(ppw->in[0] + (size_t)m * DM, XB1 + (size_t)m * DM, SS1 + (size_t)m * 32, lane);
            }
            grid.sync();
            { WSPTRS(); if (tid0 == 0) (void)xb_add(&ctl[CW_BAR + XB_XCNT(xb_xcc_id())], 1u); }
        }

        for (int rep = 0; rep < REP_P2; ++rep) {
            WSPTRS_L(l);
            pg8::Gemm g{XB1, Win, T, 4096, DM, DM}; pg8::StaticOrder S; S.init(T, 4096, G, (int)blockIdx.x);
            { LAS int* tg_ = (LAS int*)(lds + 131072 + 2048); if (tid0 == 0) *tg_ = -1; __syncthreads(); }
            pg8::EpiBf16SS<0> E{PROJ, INW, SS1, (LAS float*)(lds + 131072 + 2048)};
            pg8::gemm_phase(lds, g, S, E);
        }
        GSYNC();

        if (PH(3)) {
            FRESH(); WSPTRS_L(l); LPTRS();
            {
            const int G2 = G / 2, bx = (int)blockIdx.x, c1 = (bx < G2) ? bx : (1 << 20), c2 = (bx >= G2) ? bx - G2 : (1 << 20);
            { pg8::Gemm g{XB1, Win + (size_t)4096 * DM, T, 512, DM, DM}; pg8::StaticOrder S; S.init(T, 512, G2, c1);
              { LAS int* tg_ = (LAS int*)(lds + 131072 + 2048); if (tid0 == 0) *tg_ = -1; __syncthreads(); }
              pg8::EpiBf16SS<0> E{PROJ + 4096, INW, SS1, (LAS float*)(lds + 131072 + 2048)}; pg8::gemm_phase(lds, g, S, E); }
            { pg8::Gemm g{PROJ + C_CQ, Wuq, T, 768, 512, INW}; pg8::StaticOrder S; S.init(T, 768, G2, c2);
              pg8::EpiRowScale<768, 448> E{QA, PROJ + C_CQ, (LAS float*)(lds + 131072 + 64)}; pg8::gemm_phase(lds, g, S, E); }
            { pg8::Gemm g{PROJ + C_CKV, Wukv, T, 1024, 512, INW}; pg8::StaticOrder S; S.init(T, 1024, G2, c2);
              pg8::EpiRowScale<1024, 512> E{KVA, PROJ + C_CKV, (LAS float*)(lds + 131072 + 64)}; pg8::gemm_phase(lds, g, S, E); }
            }
            for (int rp = 0; rp < REP_ROW; ++rp) {
            bf16_t* rbase = (rp == 0) ? PROJ : XB1; const int rstride = (rp == 0) ? INW : 4096;
            const int e1 = (lane < 32) ? lane : lane + 32, e2 = e1 + 32;
            const float gk1 = g_kn_b[e1], gk2 = g_kn_b[e2];
            for (int t0 = gw; t0 < T; t0 += 2 * NGW) {
                float kx1[2], kx2[2], b1[2][2], b2[2][2], c1[2][6], c2[2][6]; f32x2 csb[2], csc[2], csa[2];
#pragma unroll
                for (int q = 0; q < 2; ++q) { const int t = t0 + q * NGW; const bf16_t* row = rbase + (size_t)t * rstride; const int pos = t & (SEQ - 1);
                    const f32x2* tA = tabA + (size_t)pos * 32; const f32x2* tC = tabC + (size_t)pos * 64;
                    const f32x2* tR = tabA + (size_t)(pos >> 6) * 32; const f32x2* tCl = tabA + (size_t)(pos & 63) * 32;
                    csb[q] = (lane < 32) ? tR[lane] : tCl[lane - 32]; csc[q] = tC[lane]; csa[q] = tA[lane & 31];
                    const bf16_t* kr = row + C_KR; kx1[q] = bf2f(kr[lane & 31]); kx2[q] = bf2f(kr[(lane & 31) + 32]);
#pragma unroll
                    for (int hh = 0; hh < 2; ++hh) { const bf16_t* hp = row + C_BK + hh * 128; b1[q][hh] = bf2f(hp[e1]); b2[q][hh] = bf2f(hp[e2]); }
#pragma unroll
                    for (int hh = 0; hh < 6; ++hh) { const bf16_t* hp = row + C_CK + hh * 128; c1[q][hh] = bf2f(hp[lane]); c2[q][hh] = bf2f(hp[lane + 64]); } }
#pragma unroll
                for (int q = 0; q < 2; ++q) { const int t = t0 + q * NGW; bf16_t* row = rbase + (size_t)t * rstride;
                    bf16_t* kr = row + C_KR;
                    if (lane < 32) { kr[lane] = f2bf(kx1[q] * csa[q].x - kx2[q] * csa[q].y); kr[lane + 32] = f2bf(kx1[q] * csa[q].y + kx2[q] * csa[q].x); }
#pragma unroll
                    for (int hh = 0; hh < 2; ++hh) { bf16_t* hp = row + C_BK + hh * 128;
                        const float r = rsqrtf(wave_sum(b1[q][hh] * b1[q][hh] + b2[q][hh] * b2[q][hh]) * (1.0f / 128.0f) + EPS);
                        const float y1 = b1[q][hh] * r * gk1, y2 = b2[q][hh] * r * gk2;
                        hp[e1] = f2bf(y1 * csb[q].x - y2 * csb[q].y); hp[e2] = f2bf(y1 * csb[q].y + y2 * csb[q].x); }
#pragma unroll
                    for (int hh = 0; hh < 6; ++hh) { bf16_t* hp = row + C_CK + hh * 128;
                        hp[lane] = f2bf(c1[q][hh] * csc[q].x - c2[q][hh] * csc[q].y); hp[lane + 64] = f2bf(c1[q][hh] * csc[q].y + c2[q][hh] * csc[q].x); } }
            }
            }
        }
        GSYNC();

        for (int rep = 0; rep < REP_ATTN; ++rep) {
            FRESH(); WSPTRS(); LPTRS();
            LAS int* slot = (LAS int*)(lds + 131072);
            for (;;) {
                __syncthreads();
                if (tid == 0) *slot = (int)atomicAdd(&ctl[l + 8 * rep], 1u);
                __syncthreads();
                const int u = *slot;
                if (u >= 1792) break;
                if (u < 256) {
                    const int b = u >> 6, h = (u >> 4) & 3, qb = u & 15; const size_t t0 = (size_t)b * SEQ;
                    attn_pipe<192, 0>(lds, QA + (t0 + qb * 256) * 768 + h * 192, KVA + t0 * 1024 + h * 256, PROJ + t0 * INW + C_KR,
                                      OAB + (t0 + qb * 256) * 1280 + h * 128, tabA, qb * 256, nullptr);
                } else if (u < 640) {
                    const int v = u - 256; const int b = v / 96, rem = v % 96, head = rem >> 4, qb = rem & 15, kvh = head / 3; const size_t t0 = (size_t)b * SEQ;
                    attn_pipe<128, 1>(lds, PROJ + (t0 + qb * 256) * INW + C_BQ + head * 128, PROJ + t0 * INW + C_BK + kvh * 128, nullptr,
                                      OAB + (t0 + qb * 256) * 1280 + 512 + head * 128, tabA, qb * 256, g_qn_b);
                } else {
                    const int v = u - 640; const int br = v / 384, rem = v % 384, b = rem / 96, h = (rem >> 4) % 6, u16 = rem & 15;
                    const int dil = (br == 0) ? 1 : (br == 1 ? 4 : 16); const int L = SEQ / dil, upr = 16 / dil, residue = u16 / upr, qb = u16 % upr, q0 = qb * 256;
                    const size_t tokb = (size_t)b * SEQ + residue; const int kbase = q0 - 64;
                    const int ktb = (kbase < 0) ? 1 : 0; int kte = (L - kbase) / 64; if (kte > 6) kte = 6;
                    for (int rc_ = 0; rc_ < REP_C; ++rc_)
                    attn_unit<128, 2>(lds, PROJ + (tokb + (size_t)q0 * dil) * INW + C_CQ3 + h * 128, (long)dil * INW, PROJ + tokb * INW + C_CK + h * 128, (long)dil * INW, nullptr, 0,
                                      PROJ + tokb * INW + C_CV + h * 128, (long)dil * INW, OC + ((size_t)br * T + tokb + (size_t)q0 * dil) * 768 + h * 128, (long)dil * 768,
                                      LSEB + ((size_t)br * T + tokb + (size_t)q0 * dil) * 8 + h, (long)dil * 8,
                                      tabC, q0 * dil + residue, dil, ktb, kte, kbase, q0, 0.08838834764831845f * LOG2E, 0.08838834764831845f);
                }
            }
        }
        if (l + 1 < DEPTH) {
            FRESH(); WSPTRS();
            LAS int* slot = (LAS int*)(lds + 131072);
            LAS float* scr = (LAS float*)(lds + wid * 16384);
            unsigned char* wbn = ws + (((l + 1) & 1) ? WS_WB1 : WS_WIN);
            for (;;) {
                __syncthreads();
                if (tid == 0) *slot = (int)atomicAdd(&ctl[16 + l], 1u);
                __syncthreads();
                const int bi = *slot;
                if (bi >= NIT / 8) break;
                conv_item(bi * 8 + wid, l + 1, ppw, wbn, scr, lane);
            }
        }
        GSYNC();

        for (int rep = 0; rep < REP_P5; ++rep) {
            FRESH(); WSPTRS(); LPTRS();
            for (int t0 = gw; t0 < T; t0 += 2 * NGW) {
                u32x2 ra[2][2], rb[2][3], rc[2][3][3]; float rl[2][3][3];
#pragma unroll
                for (int q = 0; q < 2; ++q) { const int t = t0 + q * NGW; const bf16_t* oab = OAB + (size_t)t * 1280;
#pragma unroll
                    for (int j = 0; j < 2; ++j) ra[q][j] = *(const u32x2*)(oab + (lane + 64 * j) * 4);
#pragma unroll
                    for (int j = 0; j < 3; ++j) rb[q][j] = *(const u32x2*)(oab + 512 + (lane + 64 * j) * 4);
#pragma unroll
                    for (int j = 0; j < 3; ++j) { const int ci = lane + 64 * j, col = ci * 4, head = ci >> 5;
#pragma unroll
                        for (int br = 0; br < 3; ++br) { rl[q][j][br] = LSEB[((size_t)br * T + t) * 8 + head]; rc[q][j][br] = *(const u32x2*)(OC + ((size_t)br * T + t) * 768 + col); } } }
#pragma unroll
                for (int q = 0; q < 2; ++q) { const int t = t0 + q * NGW; bf16_t* mx = H + (size_t)t * DM; const float* gr = g_out;
                    f32x4 va[2], vb_[3], vc[3]; float sa = 0.f, sb = 0.f, sc_ = 0.f;
#pragma unroll
                    for (int j = 0; j < 2; ++j) { const u32x2 w = ra[q][j]; va[j] = (f32x4){bflo(w.x), bfhi(w.x), bflo(w.y), bfhi(w.y)};
                        sa += (va[j].x * va[j].x + va[j].y * va[j].y) + (va[j].z * va[j].z + va[j].w * va[j].w); }
#pragma unroll
                    for (int j = 0; j < 3; ++j) { const u32x2 w = rb[q][j]; vb_[j] = (f32x4){bflo(w.x), bfhi(w.x), bflo(w.y), bfhi(w.y)};
                        sb += (vb_[j].x * vb_[j].x + vb_[j].y * vb_[j].y) + (vb_[j].z * vb_[j].z + vb_[j].w * vb_[j].w); }
#pragma unroll
                    for (int j = 0; j < 3; ++j) { const float l0 = rl[q][j][0], l1 = rl[q][j][1], l2 = rl[q][j][2];
                        const float mxl = fmaxf(l0, fmaxf(l1, l2)); float w0 = __expf(l0 - mxl), w1 = __expf(l1 - mxl), w2 = __expf(l2 - mxl);
                        const float inv = 1.0f / (w0 + w1 + w2); w0 *= inv; w1 *= inv; w2 *= inv;
                        const u32x2 a = rc[q][j][0], b = rc[q][j][1], c = rc[q][j][2];
                        vc[j].x = w0 * bflo(a.x) + w1 * bflo(b.x) + w2 * bflo(c.x); vc[j].y = w0 * bfhi(a.x) + w1 * bfhi(b.x) + w2 * bfhi(c.x);
                        vc[j].z = w0 * bflo(a.y) + w1 * bflo(b.y) + w2 * bflo(c.y); vc[j].w = w0 * bfhi(a.y) + w1 * bfhi(b.y) + w2 * bfhi(c.y);
                        sc_ += (vc[j].x * vc[j].x + vc[j].y * vc[j].y) + (vc[j].z * vc[j].z + vc[j].w * vc[j].w); }
                    const float ra_ = rsqrtf(wave_sum(sa) * (1.0f / 512.0f) + EPS), rb_ = rsqrtf(wave_sum(sb) * (1.0f / 768.0f) + EPS), rc_ = rsqrtf(wave_sum(sc_) * (1.0f / 768.0f) + EPS);
#pragma unroll
                    for (int j = 0; j < 2; ++j) { const int col = (lane + 64 * j) * 4; const f32x4 gg = *(const f32x4*)(gr + col); const f32x4 y = va[j] * ra_ * gg;
                        u32x2 w; w.x = cvtpk(y.x, y.y); w.y = cvtpk(y.z, y.w); *(u32x2*)(mx + col) = w; }
#pragma unroll
                    for (int j = 0; j < 3; ++j) { const int col = 512 + (lane + 64 * j) * 4; const f32x4 gg = *(const f32x4*)(gr + col); const f32x4 y = vb_[j] * rb_ * gg;
                        u32x2 w; w.x = cvtpk(y.x, y.y); w.y = cvtpk(y.z, y.w); *(u32x2*)(mx + col) = w; }
#pragma unroll
                    for (int j = 0; j < 3; ++j) { const int col = 1280 + (lane + 64 * j) * 4; const f32x4 gg = *(const f32x4*)(gr + col); const f32x4 y = vc[j] * rc_ * gg;
                        u32x2 w; w.x = cvtpk(y.x, y.y); w.y = cvtpk(y.z, y.w); *(u32x2*)(mx + col) = w; } }
            }
        }
        GSYNC();

        for (int rep = 0; rep < REP_SYNC; ++rep) GSYNC();
        for (int rep = 0; rep < REP_P6X; ++rep) {
            WSPTRS_L(l); pg8::Gemm g{H, Wout, T, DM, DM, DM}; pg8::StaticOrder S; S.init(T, DM, G, (int)blockIdx.x);
            pg8::EpiBf16<0> E{XB2, DM}; pg8::gemm_phase(lds, g, S, E);
        }
        if (PH(6)) {
            WSPTRS_L(l); LPTRS(); const float* xsrc = (l == 0) ? x_in : X;
            pg8::Gemm g{H, Wout, T, DM, DM, DM}; pg8::StaticOrder S; S.init(T, DM, G, (int)blockIdx.x);
            pg8::EpiResidualSS E{xsrc, X, XB2, SS2};
            pg8::gemm_phase(lds, g, S, E);
        }
        GSYNC();


        for (int rep = 0; rep < REP_FF1; ++rep) {
            WSPTRS_L(l);
            pg8::Gemm g{XB2, W1, T, DFF, DM, DM}; pg8::StaticOrder S; S.init(T, DFF, G, (int)blockIdx.x);
            { LAS int* tg_ = (LAS int*)(lds + 131072 + 2048); if (tid0 == 0) *tg_ = -1; __syncthreads(); }
            pg8::EpiBf16SS<1> E{U, DFF, SS2, (LAS float*)(lds + 131072 + 2048)};
            pg8::gemm_phase(lds, g, S, E);
        }
        GSYNC();

        for (int rep = 0; rep < REP_FF2X; ++rep) {
            WSPTRS_L(l); pg8::Gemm g{U, W2, T, DM, DFF, DFF}; pg8::StaticOrder S; S.init(T, DM, G, (int)blockIdx.x);
            pg8::EpiBf16<0> E{H, DM}; pg8::gemm_phase(lds, g, S, E);
        }
        if (PH(9)) {
            WSPTRS_L(l);
            pg8::Gemm g{U, W2, T, DM, DFF, DFF}; pg8::StaticOrder S; S.init(T, DM, G, (int)blockIdx.x);
            S.reverse_rounds();
            pg8::EpiResidualSS E{X, X, XB1, SS1};
            pg8::gemm_phase(lds, g, S, E);
        }
        GSYNC();
    }
    FRESH(); WSPTRS();
    for (int m = gw; m < T; m += NGW) rms_row_f32(X + (size_t)m * DM, ppw->in[14], ppw->out + (size_t)m * DM, lane);
}

extern "C" void kernel_launch(void* const* d_in, const int* in_sizes, int n_in, void* d_out, int out_size, void* d_ws, size_t ws_size, hipStream_t stream) {
    static int grid_blocks = 0;
    if (grid_blocks == 0) {
        if (n_in != 15 || out_size != T * DM || ws_size < WS_END) { fprintf(stderr, "kernel_launch: unexpected shapes (n_in %d out %d ws %zu need %zu)\n", n_in, out_size, ws_size, (size_t)WS_END); grid_blocks = -1; return; }
        int dev = 0, cus = 0, per_cu = 0;
        hipGetDevice(&dev);
        hipDeviceGetAttribute(&cus, hipDeviceAttributeMultiprocessorCount, dev);
        if (hipFuncSetAttribute((const void*)mega_fwd, hipFuncAttributeMaxDynamicSharedMemorySize, LDS_BYTES) != hipSuccess) { fprintf(stderr, "kernel_launch: hipFuncSetAttribute failed\n"); grid_blocks = -1; return; }
        if (hipOccupancyMaxActiveBlocksPerMultiprocessor(&per_cu, (const void*)mega_fwd, 512, LDS_BYTES) != hipSuccess || per_cu < 1) { fprintf(stderr, "kernel_launch: occupancy query gave %d\n", per_cu); per_cu = 1; }
        (void)hipGetLastError();
        grid_blocks = cus * per_cu;
    }
    if (grid_blocks < 0) return;
    Params p{};
    for (int i = 0; i < 15; ++i) p.in[i] = (const float*)d_in[i];
    p.out = (float*)d_out; p.ws = (unsigned char*)d_ws;
    void* args[] = {&p};
    hipError_t e = hipLaunchCooperativeKernel((void*)mega_fwd, dim3(grid_blocks), dim3(512), args, LDS_BYTES, stream);
    if (e != hipSuccess) fprintf(stderr, "cooperative launch failed: %s (grid %d)\n", hipGetErrorString(e), grid_blocks);
}
```
